# Optimizing an MI355X kernel written in HIP

```python
import math
import jax, jax.numpy as jnp
from jax import lax
import numpy as np

D_MODEL = 1024
BATCH = 2
SEQ = 8192
DEPTH = 4

GRID_W = 64
CTX_LEN = 256
EPS = 1e-6

NA_HEADS = 4
NA_HEAD_DIM = 64
NA_WIN_H = 8
NA_WIN_W = 16
MLA_HEADS = 4
MLA_Q_LORA = 256
MLA_KV_LORA = 128
MLA_NOPE = 64
MLA_ROPE = 32
MLA_V = 64
ROPE_BASE = 10000.0
Q_BLOCK = 128
GDN_HEADS = 4
GDN_DK = 64
GDN_DV = 64
GDN_CONV = 4
GDN_CHUNK = 64
S5_GROUPS = 16
S5_GROUP_CH = 16
S5_STATE = 64
D_FF = 4 * D_MODEL

NA_W = NA_HEADS * NA_HEAD_DIM
MLA_W = MLA_HEADS * MLA_V
GDN_W = GDN_HEADS * GDN_DV
S5_W = S5_GROUPS * S5_GROUP_CH
BRANCH_W = 256
N_BRANCH = 4
IN_SPLITS = (3 * NA_W,
             MLA_Q_LORA,
             MLA_KV_LORA + MLA_ROPE,
             2 * GDN_HEADS * GDN_DK + GDN_W,
             GDN_W,
             2 * GDN_HEADS,
             2 * GDN_HEADS,
             S5_W,
             N_BRANCH * D_MODEL)
D_IN = 768 + 256 + 160 + 768 + 256 + 8 + 8 + 256 + 4096

kernel_name = 'hybrid_gated_branch_diffusion_block'


def rms_norm(x, gain):
    xf = x.astype(jnp.float32)
    y = xf * lax.rsqrt(jnp.mean(xf * xf, axis=-1, keepdims=True) + EPS)
    return (y * gain.astype(jnp.float32)).astype(x.dtype)


def l2_normalize(x):
    xf = x.astype(jnp.float32)
    return xf * lax.rsqrt(jnp.sum(xf * xf, axis=-1, keepdims=True) + EPS)


def split_cols(z, sizes):
    out, off = [], 0
    for n in sizes:
        out.append(z[..., off:off + n])
        off += n
    return out


def to_heads(a, n_heads):
    return a.reshape(a.shape[:2] + (n_heads, a.shape[-1] // n_heads))


def axial_rope(x, rows, cols):
    half = x.shape[-1] // 2
    quarter = half // 2
    inv_freq = ROPE_BASE ** (-jnp.arange(quarter, dtype=jnp.float32) / quarter)

    def rotate(xa, pos):
        ang = pos.astype(jnp.float32)[:, None] * inv_freq[None, :]
        cos = jnp.cos(ang)[None, :, None, :].astype(x.dtype)
        sin = jnp.sin(ang)[None, :, None, :].astype(x.dtype)
        x1, x2 = xa[..., :quarter], xa[..., quarter:]
        return jnp.concatenate([x1 * cos - x2 * sin, x2 * cos + x1 * sin], axis=-1)

    return jnp.concatenate([rotate(x[..., :half], rows), rotate(x[..., half:], cols)], axis=-1)


def dense_attention(q, k, v):
    B_, T, H, dq = q.shape
    scale = dq ** -0.5
    nb = T // Q_BLOCK
    qb = jnp.moveaxis(q.reshape(B_, nb, Q_BLOCK, H, dq), 1, 0)

    def attend(qblk):
        s = jnp.einsum('bqhd,bnhd->bhqn', qblk, k).astype(jnp.float32) * scale
        p = jax.nn.softmax(s, axis=-1).astype(v.dtype)
        return jnp.einsum('bhqn,bnhd->bqhd', p, v)

    o = lax.map(attend, qb)
    return jnp.moveaxis(o, 0, 1).reshape(B_, T, H, v.shape[-1])


def neighborhood_attention(q, k, v, k_ctx, v_ctx, rpb):
    B_, S, H, d = q.shape
    rows = S // GRID_W
    kh = min(NA_WIN_H, rows)
    qg = q.reshape(B_, rows, GRID_W, H, d)
    kg = k.reshape(B_, rows, GRID_W, H, d)
    vg = v.reshape(B_, rows, GRID_W, H, d)
    r = jnp.arange(rows)
    row_start = jnp.clip(r - kh // 2, 0, rows - kh)
    row_idx = row_start[:, None] + jnp.arange(kh)[None, :]
    k_band = kg[:, row_idx]
    v_band = vg[:, row_idx]
    col = jnp.arange(GRID_W)
    col_start = jnp.clip(col - NA_WIN_W // 2, 0, GRID_W - NA_WIN_W)
    col_in = (col[None, :] >= col_start[:, None]) & (col[None, :] < col_start[:, None] + NA_WIN_W)
    scale = d ** -0.5
    s_band = jnp.einsum('brqhd,brikhd->bhrqik', qg, k_band).astype(jnp.float32) * scale
    di = row_idx - r[:, None] + NA_WIN_H - 1
    dj = jnp.clip(col[None, :] - col[:, None] + NA_WIN_W - 1, 0, 2 * NA_WIN_W - 2)
    bias = rpb.astype(jnp.float32)[:, di[:, None, :, None], dj[None, :, None, :]]
    s_band = jnp.where(col_in[:, None, :], s_band + bias[None], -jnp.inf)
    s_ctx = jnp.einsum('brqhd,blhd->bhrql', qg, k_ctx).astype(jnp.float32) * scale
    n_band = kh * GRID_W
    scores = jnp.concatenate([s_band.reshape(B_, H, rows, GRID_W, n_band), s_ctx], axis=-1)
    p = jax.nn.softmax(scores, axis=-1).astype(v.dtype)
    p_band = p[..., :n_band].reshape(B_, H, rows, GRID_W, kh, GRID_W)
    o = (jnp.einsum('bhrqik,brikhd->brqhd', p_band, v_band)
         + jnp.einsum('bhrql,blhd->brqhd', p[..., n_band:], v_ctx))
    return o.reshape(B_, S, H, d)


def mla_queries(cq, q_norm, w_uq, rows, cols):
    B_, T, _ = cq.shape
    q = (rms_norm(cq, q_norm) @ w_uq).reshape(B_, T, MLA_HEADS, MLA_NOPE + MLA_ROPE)
    if rows is None:
        return q
    return jnp.concatenate([q[..., :MLA_NOPE], axial_rope(q[..., MLA_NOPE:], rows, cols)], axis=-1)


def mla_keys_values(ckv, kv_norm, w_ukv, rows, cols):
    B_, T, _ = ckv.shape
    c_kv, k_rope = ckv[..., :MLA_KV_LORA], ckv[..., MLA_KV_LORA:]
    kv = (rms_norm(c_kv, kv_norm) @ w_ukv).reshape(B_, T, MLA_HEADS, MLA_NOPE + MLA_V)
    k_rope = k_rope[:, :, None, :]
    if rows is not None:
        k_rope = axial_rope(k_rope, rows, cols)
    k = jnp.concatenate([kv[..., :MLA_NOPE], jnp.broadcast_to(k_rope, (B_, T, MLA_HEADS, MLA_ROPE))], axis=-1)
    return k, kv[..., MLA_NOPE:]


def short_conv(x, w):
    return lax.conv_general_dilated(
        x, w[:, None, :].astype(x.dtype), window_strides=(1,),
        padding=[(GDN_CONV // 2, GDN_CONV - 1 - GDN_CONV // 2)],
        dimension_numbers=('NWC', 'WIO', 'NWC'), feature_group_count=x.shape[-1])


def gdn_prepare(qkv, a, b, conv_w, a_log, dt_bias):
    B_, T, _ = qkv.shape
    qkv = jax.nn.silu(short_conv(qkv, conv_w))
    q, k, v = split_cols(qkv, (GDN_HEADS * GDN_DK, GDN_HEADS * GDN_DK, GDN_W))
    q = l2_normalize(to_heads(q, GDN_HEADS)) * (GDN_DK ** -0.5)
    k = l2_normalize(to_heads(k, GDN_HEADS))
    v = to_heads(v, GDN_HEADS).astype(jnp.float32)
    a = a.reshape(B_, T, 2, GDN_HEADS).astype(jnp.float32)
    g = -jnp.exp(a_log.astype(jnp.float32)) * jax.nn.softplus(a + dt_bias.astype(jnp.float32))
    beta = jax.nn.sigmoid(b.reshape(B_, T, 2, GDN_HEADS).astype(jnp.float32))
    return q, k, v, g, beta


def to_chunks(a):
    B_, T = a.shape[:2]
    a = jnp.moveaxis(a, 2, 1)
    return a.reshape((B_, a.shape[1], T // GDN_CHUNK, GDN_CHUNK) + a.shape[3:])


def gated_delta_chunked(q, k, v, g, beta, s0, with_output):
    B_, T, H, _ = q.shape
    q, k, v, g, beta = [to_chunks(t.astype(jnp.float32)) for t in (q, k, v, g, beta)]
    dv = v.shape[-1]
    gc = jnp.cumsum(g, axis=-1)
    idx = jnp.arange(GDN_CHUNK)
    incl = idx[:, None] >= idx[None, :]
    strict = idx[:, None] > idx[None, :]
    dec_incl = jnp.exp(jnp.where(incl, gc[..., :, None] - gc[..., None, :], -jnp.inf))
    dec_strict = jnp.where(strict, dec_incl, 0.0)
    kk = jnp.einsum('bhnid,bhnjd->bhnij', k, k)
    a_mat = jnp.eye(GDN_CHUNK, dtype=jnp.float32) + beta[..., :, None] * kk * dec_strict
    rhs = jnp.concatenate([v * beta[..., None], k * (beta * jnp.exp(gc))[..., None]], axis=-1)
    sol = lax.linalg.triangular_solve(a_mat, rhs, left_side=True, lower=True)
    u_val, k_cum = sol[..., :dv], sol[..., dv:]
    k_tail = k * jnp.exp(gc[..., -1:] - gc)[..., None]
    g_last = jnp.exp(gc[..., -1])
    xs = (u_val, k_cum, k_tail, g_last)
    if with_output:
        qk = jnp.einsum('bhnid,bhnjd->bhnij', q, k) * dec_incl
        xs = xs + (q * jnp.exp(gc)[..., None], qk)
    xs = tuple(jnp.moveaxis(t, 2, 0) for t in xs)

    def step(S, inp):
        u, kc, kt, gl = inp[:4]
        v_new = u - jnp.einsum('bhcd,bhde->bhce', kc, S)
        S_next = S * gl[..., None, None] + jnp.einsum('bhcd,bhce->bhde', kt, v_new)
        if not with_output:
            return S_next, None
        qd, qk_c = inp[4], inp[5]
        o = jnp.einsum('bhcd,bhde->bhce', qd, S) + jnp.einsum('bhij,bhje->bhie', qk_c, v_new)
        return S_next, o

    s_fin, o = lax.scan(step, s0, xs)
    if not with_output:
        return None, s_fin
    return o.transpose(1, 0, 3, 2, 4).reshape(B_, T, H, dv), s_fin


def gdn_bidirectional(q, k, v, g, beta, s0_fwd, s0_bwd, with_output):
    fl = lambda t: jnp.flip(t, axis=1)
    o_f, s_f = gated_delta_chunked(q, k, v, g[:, :, 0], beta[:, :, 0], s0_fwd, with_output)
    o_b, s_b = gated_delta_chunked(fl(q), fl(k), fl(v), fl(g[:, :, 1]), fl(beta[:, :, 1]), s0_bwd, with_output)
    o = o_f + fl(o_b) if with_output else None
    return o, s_f, s_b


def gdn_output(o, z, norm_w):
    B_, T = z.shape[:2]
    y = rms_norm(o, norm_w) * jax.nn.silu(to_heads(z, GDN_HEADS).astype(jnp.float32))
    return y.reshape(B_, T, GDN_W).astype(z.dtype)


def s5_discretize(a_re, a_im, log_dt, b_re, b_im):
    f32 = jnp.float32
    lam_re = jnp.minimum(a_re.astype(f32), -1e-4)
    lam_im = a_im.astype(f32)
    dt = jnp.exp(log_dt.astype(f32))[:, None]
    mag = jnp.exp(lam_re * dt)
    lb_re = mag * jnp.cos(lam_im * dt)
    lb_im = mag * jnp.sin(lam_im * dt)
    den = lam_re * lam_re + lam_im * lam_im
    f_re = ((lb_re - 1.0) * lam_re + lb_im * lam_im) / den
    f_im = (lb_im * lam_re - (lb_re - 1.0) * lam_im) / den
    b_re = b_re.astype(f32)
    b_im = b_im.astype(f32)
    bb_re = f_re[..., None] * b_re - f_im[..., None] * b_im
    bb_im = f_re[..., None] * b_im + f_im[..., None] * b_re
    return lb_re, lb_im, bb_re, bb_im


def s5_scan(bu_re, bu_im, lb_re, lb_im, h0_re, h0_im):
    bu_re = bu_re.at[:, 0].add(lb_re * h0_re - lb_im * h0_im)
    bu_im = bu_im.at[:, 0].add(lb_re * h0_im + lb_im * h0_re)
    a_re = jnp.broadcast_to(lb_re, bu_re.shape)
    a_im = jnp.broadcast_to(lb_im, bu_im.shape)

    def combine(e1, e2):
        a1r, a1i, b1r, b1i = e1
        a2r, a2i, b2r, b2i = e2
        return (a1r * a2r - a1i * a2i, a1r * a2i + a1i * a2r,
                a2r * b1r - a2i * b1i + b2r, a2r * b1i + a2i * b1r + b2i)

    _, _, x_re, x_im = lax.associative_scan(combine, (a_re, a_im, bu_re, bu_im), axis=1)
    return x_re, x_im


def s5_direction(u, disc, c_re, c_im, h0, reverse, need_y):
    lb_re, lb_im, bb_re, bb_im = disc
    B_, T, _ = u.shape
    ug = u.reshape(B_, T, S5_GROUPS, S5_GROUP_CH).astype(jnp.float32)
    if reverse:
        ug = jnp.flip(ug, axis=1)
    bu_re = jnp.einsum('btgc,gpc->btgp', ug, bb_re)
    bu_im = jnp.einsum('btgc,gpc->btgp', ug, bb_im)
    x_re, x_im = s5_scan(bu_re, bu_im, lb_re, lb_im, h0[0], h0[1])
    final = (x_re[:, -1], x_im[:, -1])
    if not need_y:
        return None, final
    y = (jnp.einsum('btgp,gcp->btgc', x_re, c_re.astype(jnp.float32))
         - jnp.einsum('btgp,gcp->btgc', x_im, c_im.astype(jnp.float32)))
    if reverse:
        y = jnp.flip(y, axis=1)
    return y.reshape(B_, T, S5_W), final


def s5_mixer(u, u_c, need_ctx, a_re, a_im, log_dt, b_re, b_im, c_re, c_im, d_skip, glu_w, glu_b):
    disc = [s5_discretize(a_re[i], a_im[i], log_dt[i], b_re, b_im) for i in range(2)]
    zero = jnp.zeros((u.shape[0], S5_GROUPS, S5_STATE), jnp.float32)
    yc_f, h_f = s5_direction(u_c, disc[0], c_re[0], c_im[0], (zero, zero), False, need_ctx)
    yc_b, h_b = s5_direction(u_c, disc[1], c_re[1], c_im[1], (zero, zero), True, need_ctx)
    y_f, _ = s5_direction(u, disc[0], c_re[0], c_im[0], h_f, False, True)
    y_b, _ = s5_direction(u, disc[1], c_re[1], c_im[1], h_b, True, True)

    def finish(inp, yf, yb):
        y = yf + yb + d_skip.astype(jnp.float32) * inp.astype(jnp.float32)
        y = jax.nn.gelu(y)
        y = y * jax.nn.sigmoid(y @ glu_w.astype(jnp.float32) + glu_b.astype(jnp.float32))
        return y.astype(inp.dtype)

    return finish(u, y_f, y_b), (finish(u_c, yc_f, yc_b) if need_ctx else None)


def merge_branches(ys, gate_logits, w_branch, w_out):
    B_, T = gate_logits.shape[:2]
    gates = jax.nn.sigmoid(gate_logits.astype(jnp.float32)).astype(gate_logits.dtype)
    gates = gates.reshape(B_, T, N_BRANCH, D_MODEL)
    proj = jnp.einsum('btiw,iwd->btid', jnp.stack(ys, axis=2), w_branch)
    return jnp.sum(gates * proj, axis=2) @ w_out


def token_mixer(h, hc, need_ctx, w_in, na_rpb, mla_q_norm, mla_kv_norm, mla_w_uq, mla_w_ukv,
                gdn_conv, gdn_a_log, gdn_dt_bias, gdn_norm, s5_a_re, s5_a_im, s5_log_dt,
                s5_b_re, s5_b_im, s5_c_re, s5_c_im, s5_d, s5_glu_w, s5_glu_b, w_branch, w_out):
    S = h.shape[1]
    t = jnp.arange(S)
    rows, cols = t // GRID_W, t % GRID_W
    (na_qkv, mla_cq, mla_ckv, gdn_qkv, gdn_z, gdn_a, gdn_b, s5_u, gate_logits) = split_cols(h @ w_in, IN_SPLITS)
    (na_qkv_c, mla_cq_c, mla_ckv_c, gdn_qkv_c, gdn_z_c, gdn_a_c, gdn_b_c, s5_u_c, gate_logits_c) = split_cols(hc @ w_in, IN_SPLITS)

    q, k, v = [to_heads(a, NA_HEADS) for a in jnp.split(na_qkv, 3, axis=-1)]
    q_c, k_c, v_c = [to_heads(a, NA_HEADS) for a in jnp.split(na_qkv_c, 3, axis=-1)]
    y_na = neighborhood_attention(q, k, v, k_c, v_c, na_rpb).reshape(h.shape[:2] + (NA_W,))

    k_lat, v_lat = mla_keys_values(mla_ckv, mla_kv_norm, mla_w_ukv, rows, cols)
    k_ctx, v_ctx = mla_keys_values(mla_ckv_c, mla_kv_norm, mla_w_ukv, None, None)
    q_lat = mla_queries(mla_cq, mla_q_norm, mla_w_uq, rows, cols)
    y_mla = dense_attention(q_lat, jnp.concatenate([k_lat, k_ctx], axis=1),
                            jnp.concatenate([v_lat, v_ctx], axis=1)).reshape(h.shape[:2] + (MLA_W,))

    gq, gk, gv, gg, gbeta = gdn_prepare(gdn_qkv, gdn_a, gdn_b, gdn_conv, gdn_a_log, gdn_dt_bias)
    cq, ck, cv, cg, cbeta = gdn_prepare(gdn_qkv_c, gdn_a_c, gdn_b_c, gdn_conv, gdn_a_log, gdn_dt_bias)
    s_zero = jnp.zeros((h.shape[0], GDN_HEADS, GDN_DK, GDN_DV), jnp.float32)
    o_c, s_f, s_b = gdn_bidirectional(cq, ck, cv, cg, cbeta, s_zero, s_zero, need_ctx)
    o_l, _, _ = gdn_bidirectional(gq, gk, gv, gg, gbeta, s_f, s_b, True)
    y_gdn = gdn_output(o_l, gdn_z, gdn_norm)

    y_s5, y_s5_c = s5_mixer(s5_u, s5_u_c, need_ctx, s5_a_re, s5_a_im, s5_log_dt, s5_b_re, s5_b_im,
                            s5_c_re, s5_c_im, s5_d, s5_glu_w, s5_glu_b)

    y = merge_branches([y_na, y_mla, y_gdn, y_s5], gate_logits, w_branch, w_out)
    if not need_ctx:
        return y, None
    L = hc.shape[1]
    y_na_c = dense_attention(q_c, k_c, v_c).reshape(hc.shape[:2] + (NA_W,))
    y_mla_c = dense_attention(mla_queries(mla_cq_c, mla_q_norm, mla_w_uq, None, None), k_ctx, v_ctx).reshape(hc.shape[:2] + (MLA_W,))
    y_gdn_c = gdn_output(o_c, gdn_z_c, gdn_norm)
    y_c = merge_branches([y_na_c, y_mla_c, y_gdn_c, y_s5_c], gate_logits_c, w_branch, w_out)
    return y, y_c


def sq_relu_mlp(h, w1, w2):
    return jnp.square(jax.nn.relu(h @ w1)) @ w2


def setup_inputs(seed: int = 0) -> dict:
    key = jax.random.key(seed)
    ks = jax.random.split(key, 30)
    f32 = jnp.float32

    def nrm(i, shape, scale):
        return scale * jax.random.normal(ks[i], shape, f32)

    def unif(i, shape, lo, hi):
        return jax.random.uniform(ks[i], shape, f32, lo, hi)

    dt = jnp.exp(unif(15, (DEPTH, 2, GDN_HEADS), math.log(1e-3), math.log(1e-1)))
    return {
        'x': nrm(0, (BATCH, SEQ, D_MODEL), 1.0),
        'c': nrm(1, (BATCH, D_MODEL), 1.0),
        'ctx': nrm(2, (BATCH, CTX_LEN, D_MODEL), 1.0),
        'c_ctx': nrm(3, (D_MODEL,), 1.0),
        'ada_w': nrm(4, (DEPTH, D_MODEL, 6 * D_MODEL), 0.5 * D_MODEL ** -0.5),
        'ada_b': nrm(5, (DEPTH, 6 * D_MODEL), 0.02),
        'norm_gains': 1.0 + nrm(6, (DEPTH, 4, D_MODEL), 0.05),
        'w_in': nrm(7, (DEPTH, D_MODEL, D_IN), D_MODEL ** -0.5),
        'na_rpb': nrm(8, (DEPTH, NA_HEADS, 2 * NA_WIN_H - 1, 2 * NA_WIN_W - 1), 0.1),
        'mla_q_norm': 1.0 + nrm(9, (DEPTH, MLA_Q_LORA), 0.05),
        'mla_kv_norm': 1.0 + nrm(10, (DEPTH, MLA_KV_LORA), 0.05),
        'mla_w_uq': nrm(11, (DEPTH, MLA_Q_LORA, MLA_HEADS * (MLA_NOPE + MLA_ROPE)), MLA_Q_LORA ** -0.5),
        'mla_w_ukv': nrm(12, (DEPTH, MLA_KV_LORA, MLA_HEADS * (MLA_NOPE + MLA_V)), MLA_KV_LORA ** -0.5),
        'gdn_conv': nrm(13, (DEPTH, GDN_CONV, 2 * GDN_HEADS * GDN_DK + GDN_W), GDN_CONV ** -0.5),
        'gdn_a_log': jnp.log(unif(14, (DEPTH, 2, GDN_HEADS), 1.0, 16.0)),
        'gdn_dt_bias': dt + jnp.log(-jnp.expm1(-dt)),
        'gdn_norm': 1.0 + nrm(16, (DEPTH, GDN_DV), 0.05),
        's5_a_re': -0.5 + nrm(17, (DEPTH, 2, S5_GROUPS, S5_STATE), 0.01),
        's5_a_im': jnp.broadcast_to(math.pi * jnp.arange(S5_STATE, dtype=f32), (DEPTH, 2, S5_GROUPS, S5_STATE)),
        's5_log_dt': unif(18, (DEPTH, 2, S5_GROUPS), math.log(1e-3), math.log(1e-1)),
        's5_b_re': nrm(19, (DEPTH, S5_GROUPS, S5_STATE, S5_GROUP_CH), (2 * S5_GROUP_CH) ** -0.5),
        's5_b_im': nrm(20, (DEPTH, S5_GROUPS, S5_STATE, S5_GROUP_CH), (2 * S5_GROUP_CH) ** -0.5),
        's5_c_re': nrm(21, (DEPTH, 2, S5_GROUPS, S5_GROUP_CH, S5_STATE), S5_STATE ** -0.5),
        's5_c_im': nrm(22, (DEPTH, 2, S5_GROUPS, S5_GROUP_CH, S5_STATE), S5_STATE ** -0.5),
        's5_d': nrm(23, (DEPTH, S5_W), 1.0),
        's5_glu_w': nrm(24, (DEPTH, S5_W, S5_W), S5_W ** -0.5),
        's5_glu_b': nrm(25, (DEPTH, S5_W), 0.02),
        'w_branch': nrm(26, (DEPTH, N_BRANCH, BRANCH_W, D_MODEL), BRANCH_W ** -0.5),
        'w_out': nrm(27, (DEPTH, D_MODEL, D_MODEL), D_MODEL ** -0.5),
        'mlp_w1': nrm(28, (DEPTH, D_MODEL, D_FF), D_MODEL ** -0.5),
        'mlp_w2': nrm(29, (DEPTH, D_FF, D_MODEL), D_FF ** -0.5),
    }


def reference(x, c, ctx, c_ctx, ada_w, ada_b, norm_gains, w_in, na_rpb, mla_q_norm, mla_kv_norm,
              mla_w_uq, mla_w_ukv, gdn_conv, gdn_a_log, gdn_dt_bias, gdn_norm, s5_a_re, s5_a_im,
              s5_log_dt, s5_b_re, s5_b_im, s5_c_re, s5_c_im, s5_d, s5_glu_w, s5_glu_b, w_branch,
              w_out, mlp_w1, mlp_w2):
    xc = ctx
    for l in range(DEPTH):
        need_ctx = l < DEPTH - 1
        mod = jax.nn.silu(c) @ ada_w[l] + ada_b[l]
        mod_c = jax.nn.silu(c_ctx) @ ada_w[l] + ada_b[l]
        sh1, sc1, g1, sh2, sc2, g2 = jnp.split(mod[:, None, :], 6, axis=-1)
        sh1c, sc1c, g1c, sh2c, sc2c, g2c = jnp.split(mod_c[None, None, :], 6, axis=-1)

        h = rms_norm(x, norm_gains[l, 0]) * (1.0 + sc1) + sh1
        hc = rms_norm(xc, norm_gains[l, 0]) * (1.0 + sc1c) + sh1c
        y, y_c = token_mixer(h, hc, need_ctx, w_in[l], na_rpb[l], mla_q_norm[l], mla_kv_norm[l],
                             mla_w_uq[l], mla_w_ukv[l], gdn_conv[l], gdn_a_log[l], gdn_dt_bias[l],
                             gdn_norm[l], s5_a_re[l], s5_a_im[l], s5_log_dt[l], s5_b_re[l], s5_b_im[l],
                             s5_c_re[l], s5_c_im[l], s5_d[l], s5_glu_w[l], s5_glu_b[l], w_branch[l], w_out[l])
        x = x + g1 * rms_norm(y, norm_gains[l, 1])
        h = rms_norm(x, norm_gains[l, 2]) * (1.0 + sc2) + sh2
        x = x + g2 * rms_norm(sq_relu_mlp(h, mlp_w1[l], mlp_w2[l]), norm_gains[l, 3])
        if need_ctx:
            xc = xc + g1c * rms_norm(y_c, norm_gains[l, 1])
            hc = rms_norm(xc, norm_gains[l, 2]) * (1.0 + sc2c) + sh2c
            xc = xc + g2c * rms_norm(sq_relu_mlp(hc, mlp_w1[l], mlp_w2[l]), norm_gains[l, 3])
    return x
```

```cpp
#include <hip/hip_runtime.h>
#include <hip/hip_cooperative_groups.h>
#include <cstdio>
namespace cg = cooperative_groups;

typedef unsigned short u16;
using bf16x8 = __attribute__((ext_vector_type(8))) short;
using bf16x4 = __attribute__((ext_vector_type(4))) short;
using f32x4 = __attribute__((ext_vector_type(4))) float;
using u32x4 = __attribute__((ext_vector_type(4))) unsigned;
using u32x2 = __attribute__((ext_vector_type(2))) unsigned;

constexpr int DM = 1024;
constexpr int NPB = 8448;
constexpr int MROWS = 16896;
constexpr int ZLD = 2560;
constexpr int NPC = 132;
constexpr float EPS = 1e-6f;

constexpr size_t al256(size_t x) { return (x + 255) & ~(size_t)255; }
constexpr size_t O_WINA = 0;
constexpr size_t O_WG   = O_WINA + (size_t)2560 * 1024 * 2;
constexpr size_t O_WB   = O_WG + (size_t)4096 * 1024 * 2;
constexpr size_t O_WO   = O_WB + (size_t)4 * 1024 * 256 * 2;
constexpr size_t O_W1   = O_WO + (size_t)1024 * 1024 * 2;
constexpr size_t O_W2   = O_W1 + (size_t)4096 * 1024 * 2;
constexpr size_t O_WUQ  = O_W2 + (size_t)4096 * 1024 * 2;
constexpr size_t O_WUKV = O_WUQ + (size_t)384 * 256 * 2;
constexpr size_t O_WGLU = O_WUKV + (size_t)512 * 128 * 2;
constexpr size_t O_MOD  = O_WGLU + (size_t)256 * 256 * 2;
constexpr size_t O_LB   = O_MOD + (size_t)4 * 3 * 6144 * 4;
constexpr size_t O_BBR  = O_LB + (size_t)4 * 2 * 16 * 64 * 2 * 4;
constexpr size_t O_BBI  = O_BBR + (size_t)4 * 2 * 16 * 64 * 16 * 4;
constexpr size_t O_CNT  = O_BBI + (size_t)4 * 2 * 16 * 64 * 16 * 4;
constexpr size_t O_BAR  = O_CNT + 256;
constexpr size_t O_XC   = O_BAR + (size_t)3456 * 4 + 256;
constexpr size_t O_HBF  = O_XC + (size_t)512 * 1024 * 4;
constexpr size_t O_Z    = O_HBF + (size_t)MROWS * 1024 * 2;
constexpr size_t O_Y    = O_Z + (size_t)MROWS * ZLD * 2;
constexpr size_t O_R2   = O_Y + (size_t)MROWS * 1024 * 2;
constexpr size_t O_HID  = O_Z;
constexpr size_t O_F32  = O_R2 + (size_t)18 * 1024 * 1024;
constexpr size_t O_MM   = O_F32 + (size_t)MROWS * 1024 * 4;
constexpr size_t O_QM   = O_R2;
constexpr size_t O_KM   = O_QM + (size_t)MROWS * 384 * 2;
constexpr size_t O_VTM  = O_KM + (size_t)MROWS * 384 * 2;
constexpr size_t O_VTNA = O_VTM + (size_t)8 * 64 * NPB * 2;
constexpr size_t O_AB   = O_VTNA + (size_t)8 * 64 * NPB * 2;
constexpr size_t O_GQ   = O_AB + (size_t)MROWS * 16 * 4;
constexpr size_t O_GK   = O_GQ + (size_t)MROWS * 256 * 4;
constexpr size_t O_GG   = O_GK + (size_t)MROWS * 256 * 4;
constexpr size_t O_GBETA= O_GG + (size_t)MROWS * 8 * 4;
constexpr size_t O_GC   = O_GBETA + (size_t)MROWS * 8 * 4;
constexpr size_t O_U    = O_GC + (size_t)2112 * 64 * 4;
constexpr size_t O_KC   = O_U + (size_t)2112 * 4096 * 4;
constexpr size_t O_QK   = O_KC + (size_t)2112 * 4096 * 4;
constexpr size_t O_S5H  = O_QK + (size_t)2112 * 4096 * 4;
constexpr size_t O_S5PRE= O_S5H + (size_t)4 * NPC * 1024 * 2 * 4;
constexpr size_t O_GO   = O_S5PRE + (size_t)MROWS * 256 * 2;
constexpr size_t O_CQN  = O_GO;
constexpr size_t O_CKVN = O_CQN + (size_t)MROWS * 256 * 2;
constexpr size_t O_GV   = O_CKVN + (size_t)MROWS * 128 * 2;
constexpr size_t O_S5E  = O_GV + (size_t)MROWS * 256 * 2;
constexpr size_t O_END  = O_GO + (size_t)2 * MROWS * 256 * 4;
constexpr size_t WS_NEEDED = (O_END > O_MM + (size_t)MROWS * 1024 * 2) ? O_END : (O_MM + (size_t)MROWS * 1024 * 2);

struct Params {
  const float *x, *c, *ctx, *c_ctx, *ada_w, *ada_b, *norm_gains, *w_in, *na_rpb, *mla_q_norm, *mla_kv_norm,
      *mla_w_uq, *mla_w_ukv, *gdn_conv, *gdn_a_log, *gdn_dt_bias, *gdn_norm, *s5_a_re, *s5_a_im, *s5_log_dt,
      *s5_b_re, *s5_b_im, *s5_c_re, *s5_c_im, *s5_d, *s5_glu_w, *s5_glu_b, *w_branch, *w_out, *mlp_w1, *mlp_w2;
  float* out;
  char* ws;
};

__device__ __forceinline__ int TID() {
  int t = __builtin_amdgcn_workitem_id_x();
  asm volatile("" : "+v"(t));
  return t;
}
__device__ __forceinline__ char* opq(char* p) {
  size_t z = 0;
  asm volatile("" : "+s"(z));
  return p + z;
}

typedef __bf16 hbf16x2 __attribute__((ext_vector_type(2)));
typedef float hf32x2 __attribute__((ext_vector_type(2)));
__device__ __forceinline__ unsigned pk2bf(float a, float b) {
  hf32x2 v = {a, b};
  hbf16x2 r = __builtin_convertvector(v, hbf16x2);
  return *(unsigned*)&r;
}
__device__ __forceinline__ u16 f2bf(float f) { return (u16)(pk2bf(f, 0.f) & 0xffffu); }
__device__ __forceinline__ float bf2f(u16 h) { return __uint_as_float(((unsigned)h) << 16); }
__device__ __forceinline__ float sigmoidf_(float x) { return 1.f / (1.f + __expf(-x)); }
__device__ __forceinline__ float siluf_(float x) { return x / (1.f + __expf(-x)); }
__device__ __forceinline__ float wave_sum(float v) {
#pragma unroll
  for (int o = 32; o >= 1; o >>= 1) v += __shfl_xor(v, o);
  return v;
}
__device__ __forceinline__ uint2 pack4(f32x4 v) {
  uint2 r;
  r.x = pk2bf(v[0], v[1]);
  r.y = pk2bf(v[2], v[3]);
  return r;
}
__device__ __forceinline__ bf16x8 pack8(const float* v) {
  u32x4 t = {pk2bf(v[0], v[1]), pk2bf(v[2], v[3]), pk2bf(v[4], v[5]), pk2bf(v[6], v[7])};
  return *(bf16x8*)&t;
}
__device__ __forceinline__ float* xrow(const Params& P, int row) {
  int b = row >= NPB ? 1 : 0;
  int n = row - b * NPB;
  return n < 8192 ? P.out + ((size_t)b * 8192 + n) * DM : (float*)(P.ws + O_XC) + ((size_t)b * 256 + (n - 8192)) * DM;
}
__device__ __forceinline__ int tok_n(int dir, int pc, int i) {
  if (dir == 0) return pc < 4 ? 8192 + pc * 64 + i : (pc - 4) * 64 + i;
  return pc < 4 ? 8192 + (3 - pc) * 64 + 63 - i : (131 - pc) * 64 + 63 - i;
}


#define XB_TMO      128
#define XB_XCNT(j)  (256  + 64 * (j))
#define XB_XSUB(j)  (1280 + 64 * (j))
#define XB_XGEN(j)  (2304 + 64 * (j))
#define XB_TOP      3328
#define XB_TOPGEN   3392
#define XCD_BAR_WORDS 3456
#define XB_SPIN_CAP (1u << 22)
#define LAS __attribute__((address_space(3)))
__device__ __forceinline__ unsigned xb_ld(unsigned* p) { return __hip_atomic_load(p, __ATOMIC_RELAXED, __HIP_MEMORY_SCOPE_AGENT); }
__device__ __forceinline__ unsigned xb_add(unsigned* p, unsigned v) { return __hip_atomic_fetch_add(p, v, __ATOMIC_RELAXED, __HIP_MEMORY_SCOPE_AGENT); }
__device__ __forceinline__ unsigned xb_xcc_id() { return (unsigned)__builtin_amdgcn_readfirstlane((int)(__builtin_amdgcn_s_getreg((3 << 11) | 20) & 0xFu)); }
#define XB_SPIN(cond, bar) do { unsigned _sp = 0; while (cond) { __builtin_amdgcn_s_sleep(1); \
    if ((++_sp & 255u) == 0u) { if (xb_ld(&(bar)[XB_TMO])) break; if (_sp > XB_SPIN_CAP) { atomicAdd(&(bar)[XB_TMO], 1u); break; } } } } while (0)
struct XcdBarrier { unsigned* bar; unsigned x; volatile LAS unsigned* st; };
__device__ __forceinline__ XcdBarrier xcd_barrier_post(unsigned* bar, volatile LAS unsigned* st) {
  XcdBarrier b; b.bar = bar; b.x = xb_xcc_id(); b.st = st;
  if (threadIdx.x == 0) (void)xb_add(&bar[XB_XCNT(b.x)], 1u);
  return b;
}
__device__ __forceinline__ void xcd_barrier_complete(unsigned* bar, unsigned x, unsigned& nloc, unsigned& nx) {
  const unsigned G = gridDim.x * gridDim.y * gridDim.z;
  unsigned sum, cnt, mine, sp = 0u;
  for (;;) {
    sum = 0u; cnt = 0u; mine = 0u;
#pragma unroll
    for (unsigned j = 0; j < 16; ++j) { const unsigned c = xb_ld(&bar[XB_XCNT(j)]); sum += c; cnt += (c > 0u) ? 1u : 0u; mine = (j == x) ? c : mine; }
    if (sum == G) break;
    __builtin_amdgcn_s_sleep(1);
    if ((++sp & 255u) == 0u) { if (xb_ld(&bar[XB_TMO])) break; if (sp > XB_SPIN_CAP) { atomicAdd(&bar[XB_TMO], 1u); break; } }
  }
  nloc = mine > 0u ? mine : 1u; nx = cnt > 0u ? cnt : 1u;
}
__device__ __forceinline__ void xcd_barrier(const XcdBarrier& b, unsigned* bar_in) {
  asm volatile("s_waitcnt vmcnt(0)" ::: "memory");
  __syncthreads();
  if (threadIdx.x == 0) {
    unsigned* bar = bar_in;
    __builtin_amdgcn_s_waitcnt(0);
    unsigned nloc = b.st[0], nx = b.st[1];
    if (nloc == 0u) { xcd_barrier_complete(bar, b.x, nloc, nx); b.st[0] = nloc; b.st[1] = nx; }
    const unsigned old = xb_add(&bar[XB_XSUB(b.x)], 1u);
    const unsigned gen = old / nloc;
    if (old + 1u == (gen + 1u) * nloc) {
      __builtin_amdgcn_fence(__ATOMIC_RELEASE, "agent");
      asm volatile("s_waitcnt vmcnt(0)" ::: "memory");
      const unsigned og = xb_add(&bar[XB_TOP], 1u);
      const unsigned tg = og / nx;
      if (og + 1u == (tg + 1u) * nx) xb_add(&bar[XB_TOPGEN], 1u);
      else XB_SPIN(xb_ld(&bar[XB_TOPGEN]) == tg, bar);
      __builtin_amdgcn_fence(__ATOMIC_ACQUIRE, "agent");
      xb_add(&bar[XB_XGEN(b.x)], 1u);
      asm volatile("s_waitcnt vmcnt(0)" ::: "memory");
    } else {
      XB_SPIN(xb_ld(&bar[XB_XGEN(b.x)]) == gen, bar);
      __builtin_amdgcn_fence(__ATOMIC_ACQUIRE, "agent");
      asm volatile("s_waitcnt vmcnt(0)" ::: "memory");
    }
  }
  __syncthreads();
}

template <int NT, bool PRE>
__device__ __forceinline__ void gemm_core_r(const u16* __restrict__ pa, size_t sa32, const u16* const (&pbv)[NT], int K,
                                            f32x4 (&acc)[4][NT], u16* sA, u16* sB, int tid, u32x4 (&ra0)[4],
                                            u32x4 (&rb0)[NT], u32x4 (&ra1)[4], u32x4 (&rb1)[NT]) {
  constexpr int BN = NT * 32;
  constexpr int NB_ = BN / 32;
  constexpr int STG = 256 * 64;
  const int lane = tid & 63, w = tid >> 6;
  const int wm = w >> 1, wn = w & 1;
#define GLOAD(ra, rb, koff)                                                        \
  {                                                                                \
    _Pragma("unroll") for (int j = 0; j < 4; j++) ra[j] = *(const u32x4*)(pa + j * sa32 + (koff));   \
    _Pragma("unroll") for (int j = 0; j < NB_; j++) rb[j] = *(const u32x4*)(pbv[j] + (koff));         \
  }
  const int wsw = ((tid & 7) ^ ((tid >> 4) & 7)) * 8;
  const int rsw = (lane & 15) >> 1;
#define LSTORE(ra, rb, st)                                                                         \
  {                                                                                                \
    _Pragma("unroll") for (int j = 0; j < 4; j++)                                                  \
        *(u32x4*)(sA + (st) * STG + ((tid >> 3) + 32 * j) * 64 + wsw) = ra[j];                     \
    _Pragma("unroll") for (int j = 0; j < NB_; j++)                                                \
        *(u32x4*)(sB + (st) * STG + ((tid >> 3) + 32 * j) * 64 + wsw) = rb[j];                     \
  }
#define COMPUTE(st)                                                                                                  \
  {                                                                                                                  \
    _Pragma("unroll") for (int ks = 0; ks < 2; ks++) {                                                               \
      bf16x8 af[4], bfr[NT];                                                                                         \
      _Pragma("unroll") for (int mi = 0; mi < 4; mi++) af[mi] =                                                      \
          *(const bf16x8*)(sA + (st) * STG + (wm * 64 + mi * 16 + (lane & 15)) * 64 + (((ks * 4 + (lane >> 4)) ^ rsw) * 8)); \
      _Pragma("unroll") for (int ni = 0; ni < NT; ni++) bfr[ni] =                                                    \
          *(const bf16x8*)(sB + (st) * STG + (wn * (BN / 2) + ni * 16 + (lane & 15)) * 64 + (((ks * 4 + (lane >> 4)) ^ rsw) * 8)); \
      _Pragma("unroll") for (int mi = 0; mi < 4; mi++)                                                               \
        _Pragma("unroll") for (int ni = 0; ni < NT; ni++)                                                            \
          acc[mi][ni] = __builtin_amdgcn_mfma_f32_16x16x32_bf16(bfr[ni], af[mi], acc[mi][ni], 0, 0, 0);              \
    }                                                                                                                \
  }
  if (!PRE) {
    GLOAD(ra0, rb0, 0);
    GLOAD(ra1, rb1, 64);
  }
  __syncthreads();
  for (int k0 = 0; k0 < K; k0 += 128) {
    LSTORE(ra0, rb0, 0);
    __syncthreads();
    GLOAD(ra0, rb0, min(k0 + 128, K - 128));
    __builtin_amdgcn_sched_barrier(0);
    COMPUTE(0);
    LSTORE(ra1, rb1, 1);
    __syncthreads();
    GLOAD(ra1, rb1, min(k0 + 192, K - 64));
    __builtin_amdgcn_sched_barrier(0);
    COMPUTE(1);
  }
#undef GLOAD
#undef LSTORE
#undef COMPUTE
}
template <int NT>
__device__ __forceinline__ void gemm_core(const u16* __restrict__ pa, size_t sa32, const u16* const (&pbv)[NT], int K,
                                          f32x4 (&acc)[4][NT], u16* sA, u16* sB, int tid) {
  u32x4 ra0[4], rb0[NT], ra1[4], rb1[NT];
  gemm_core_r<NT, false>(pa, sa32, pbv, K, acc, sA, sB, tid, ra0, rb0, ra1, rb1);
}
template <int NT>
__device__ __forceinline__ void gemm_preload(const u16* __restrict__ pa, size_t sa32, const u16* const (&pbv)[NT],
                                             u32x4 (&ra0)[4], u32x4 (&rb0)[NT], u32x4 (&ra1)[4], u32x4 (&rb1)[NT]) {
#pragma unroll
  for (int j = 0; j < 4; j++) ra0[j] = *(const u32x4*)(pa + j * sa32);
#pragma unroll
  for (int j = 0; j < NT; j++) rb0[j] = *(const u32x4*)(pbv[j]);
#pragma unroll
  for (int j = 0; j < 4; j++) ra1[j] = *(const u32x4*)(pa + j * sa32 + 64);
#pragma unroll
  for (int j = 0; j < NT; j++) rb1[j] = *(const u32x4*)(pbv[j] + 64);
}
template <int NT>
__device__ __forceinline__ void gemm_main(const u16* __restrict__ A, int lda, const u16* __restrict__ Bt, int ldb,
                                          int K, int m0, int n0, f32x4 (&acc)[4][NT], u16* sA, u16* sB) {
  const int tid = TID();
  const u16* pa = A + (size_t)(m0 + (tid >> 3)) * lda + (tid & 7) * 8;
  const u16* pbv[NT];
#pragma unroll
  for (int j = 0; j < NT; j++) pbv[j] = Bt + (size_t)(n0 + (tid >> 3) + 32 * j) * ldb + (tid & 7) * 8;
  gemm_core<NT>(pa, (size_t)32 * lda, pbv, K, acc, sA, sB, tid);
}
#define GEMM_ROW(mi) (m0 + ((tq >> 6) >> 1) * 64 + (mi) * 16 + (tq & 15))
#define GEMM_COL(ni, BN) (n0 + ((tq >> 6) & 1) * ((BN) / 2) + (ni) * 16 + ((tq & 63) >> 4) * 4)

template <int NT>
__device__ __forceinline__ void zero_acc(f32x4 (&acc)[4][NT]) {
#pragma unroll
  for (int i = 0; i < 4; i++)
#pragma unroll
    for (int j = 0; j < NT; j++) acc[i][j] = f32x4{0.f, 0.f, 0.f, 0.f};
}

__device__ __forceinline__ f32x4 rope4(f32x4 v, int pos, int quad) {
  f32x4 o;
#pragma unroll
  for (int r = 0; r < 4; r++) {
    float partner = __shfl_xor(v[r], 32);
    int i = (quad & 1) * 4 + r;
    float freq = exp2f(-(float)i * (13.287712379549449f / 8.0f));
    float ang = (float)pos * freq;
    float cs = cosf(ang), sn = sinf(ang);
    o[r] = quad < 2 ? v[r] * cs - partner * sn : v[r] * cs + partner * sn;
  }
  return o;
}

__device__ __forceinline__ void conv_tile(const float* __restrict__ src, int ld, int col0, int nvalid, int K, u16* __restrict__ dst,
                          int tile, float* T) {
  const int ktiles = K >> 6;
  const int kt = tile % ktiles, nt = tile / ktiles;
  const int k0 = kt * 64, n0 = nt * 64;
  const int tid = TID(), tx = tid & 63, ty = tid >> 6;
  __syncthreads();
  float tv[16];
#pragma unroll
  for (int r = 0; r < 16; r++) {
    tv[r] = 0.f;
    if (n0 + tx < nvalid) tv[r] = src[(size_t)(k0 + ty + 4 * r) * ld + col0 + n0 + tx];
  }
#pragma unroll
  for (int r = 0; r < 16; r++) T[(ty + 4 * r) * 65 + tx] = tv[r];
  __syncthreads();
#pragma unroll
  for (int j = 0; j < 2; j++) {
    int id = tid + 256 * j;
    int nn = id >> 3, kc = id & 7;
    unsigned pk[4];
#pragma unroll
    for (int e = 0; e < 4; e++) {
      float a = T[(kc * 8 + 2 * e) * 65 + nn], b = T[(kc * 8 + 2 * e + 1) * 65 + nn];
      pk[e] = (unsigned)f2bf(a) | ((unsigned)f2bf(b) << 16);
    }
    *(uint4*)(dst + (size_t)(n0 + nn) * K + k0 + kc * 8) = make_uint4(pk[0], pk[1], pk[2], pk[3]);
  }
}

__device__ __forceinline__ void convert_weights(const Params& P, int l, float* T) {
  char* ws = opq(P.ws);
  const int c1 = 640, c2 = c1 + 1024, c3 = c2 + 256, c4 = c3 + 256, c5 = c4 + 1024, c6 = c5 + 1024, c7 = c6 + 24,
            c8 = c7 + 16, c9 = c8 + 16;
  for (int t = blockIdx.x; t < c9; t += gridDim.x) {
    if (t < c1) conv_tile(P.w_in + (size_t)l * 1024 * 6576, 6576, 0, 2480, 1024, (u16*)(ws + O_WINA), t, T);
    else if (t < c2) conv_tile(P.w_in + (size_t)l * 1024 * 6576, 6576, 2480, 4096, 1024, (u16*)(ws + O_WG), t - c1, T);
    else if (t < c3) {
      int tt = t - c2, i = tt >> 6;
      conv_tile(P.w_branch + ((size_t)l * 4 + i) * 256 * 1024, 1024, 0, 1024, 256, (u16*)(ws + O_WB) + (size_t)i * 1024 * 256, tt & 63, T);
    } else if (t < c4) conv_tile(P.w_out + (size_t)l * 1024 * 1024, 1024, 0, 1024, 1024, (u16*)(ws + O_WO), t - c3, T);
    else if (t < c5) conv_tile(P.mlp_w1 + (size_t)l * 1024 * 4096, 4096, 0, 4096, 1024, (u16*)(ws + O_W1), t - c4, T);
    else if (t < c6) conv_tile(P.mlp_w2 + (size_t)l * 4096 * 1024, 1024, 0, 1024, 4096, (u16*)(ws + O_W2), t - c5, T);
    else if (t < c7) conv_tile(P.mla_w_uq + (size_t)l * 256 * 384, 384, 0, 384, 256, (u16*)(ws + O_WUQ), t - c6, T);
    else if (t < c8) conv_tile(P.mla_w_ukv + (size_t)l * 128 * 512, 512, 0, 512, 128, (u16*)(ws + O_WUKV), t - c7, T);
    else conv_tile(P.s5_glu_w + (size_t)l * 256 * 256, 256, 0, 256, 256, (u16*)(ws + O_WGLU), t - c8, T);
  }
}

__device__ __forceinline__ void phase0(const Params& P, float* sm) {
  const int tid = TID();
  const size_t gtid = (size_t)blockIdx.x * 256 + tid, gsz = (size_t)gridDim.x * 256;
  {
    unsigned* bar = (unsigned*)(P.ws + O_BAR);
    for (size_t i = gtid; i < 3456; i += gsz) bar[i] = 0u;
  }
  {
    const float4* s = (const float4*)P.x;
    float4* d = (float4*)P.out;
#pragma unroll 8
    for (size_t i = gtid; i < (size_t)2 * 8192 * 1024 / 4; i += gsz) d[i] = s[i];
    const float4* s2 = (const float4*)P.ctx;
    float4* d2 = (float4*)(P.ws + O_XC);
    for (size_t i = gtid; i < (size_t)512 * 1024 / 4; i += gsz) d2[i] = s2[i];
  }
  float* MOD = (float*)(P.ws + O_MOD);
  for (int it = blockIdx.x; it < 4 * 96; it += gridDim.x) {
    int l = it / 96, j0 = (it % 96) * 64;
    int jj = tid & 63, kq = tid >> 6;
    float a0 = 0.f, a1 = 0.f, a2 = 0.f;
    const float* W = P.ada_w + (size_t)l * 1024 * 6144 + j0 + jj;
    for (int k = kq * 256; k < kq * 256 + 256; k++) {
      float wv = W[(size_t)k * 6144];
      a0 += siluf_(P.c[k]) * wv;
      a1 += siluf_(P.c[1024 + k]) * wv;
      a2 += siluf_(P.c_ctx[k]) * wv;
    }
    __syncthreads();
    sm[(kq * 3 + 0) * 64 + jj] = a0;
    sm[(kq * 3 + 1) * 64 + jj] = a1;
    sm[(kq * 3 + 2) * 64 + jj] = a2;
    __syncthreads();
    if (tid < 192) {
      int v = tid >> 6;
      float s = sm[(0 * 3 + v) * 64 + jj] + sm[(1 * 3 + v) * 64 + jj] + sm[(2 * 3 + v) * 64 + jj] + sm[(3 * 3 + v) * 64 + jj];
      MOD[((size_t)l * 3 + v) * 6144 + j0 + jj] = s + P.ada_b[(size_t)l * 6144 + j0 + jj];
    }
  }
  float* LB = (float*)(P.ws + O_LB);
  float* BBR = (float*)(P.ws + O_BBR);
  float* BBI = (float*)(P.ws + O_BBI);
  for (size_t i = gtid; i < 8192; i += gsz) {
    int p = i & 63, g = (i >> 6) & 15, dir = (i >> 10) & 1, l = (int)(i >> 11);
    float lam_re = fminf(P.s5_a_re[i], -1e-4f);
    float lam_im = P.s5_a_im[i];
    float dt = expf(P.s5_log_dt[(l * 2 + dir) * 16 + g]);
    float mag = expf(lam_re * dt);
    float lbr = mag * cosf(lam_im * dt), lbi = mag * sinf(lam_im * dt);
    float den = lam_re * lam_re + lam_im * lam_im;
    float fr = ((lbr - 1.f) * lam_re + lbi * lam_im) / den;
    float fi = (lbi * lam_re - (lbr - 1.f) * lam_im) / den;
    LB[i * 2] = lbr;
    LB[i * 2 + 1] = lbi;
    const float* br = P.s5_b_re + (((size_t)l * 16 + g) * 64 + p) * 16;
    const float* bi = P.s5_b_im + (((size_t)l * 16 + g) * 64 + p) * 16;
    for (int c = 0; c < 16; c++) {
      BBR[i * 16 + c] = fr * br[c] - fi * bi[c];
      BBI[i * 16 + c] = fr * bi[c] + fi * br[c];
    }
  }
}

__device__ __forceinline__ void row_phase(const Params& P, int l, int mode) {
  constexpr int R = 3;
  const int tq = TID();
  const int lane = tq & 63, w = tq >> 6;
  char* ws = opq(P.ws);
  const float* __restrict__ MOD = (const float*)(ws + O_MOD);
  const float* __restrict__ F = (const float*)(ws + O_F32);
  u16* H = (u16*)(ws + O_HBF);
  const int lh = mode == 2 ? l + 1 : l;
  const bool doH = lh < 4;
  const int gw = blockIdx.x * 4 + w, nw = gridDim.x * 4;
  const float* __restrict__ gainF = P.norm_gains + ((size_t)l * 4 + (mode == 1 ? 1 : 3)) * DM;
  const float* __restrict__ gainH = P.norm_gains + ((size_t)(doH ? lh : 0) * 4 + (mode == 1 ? 2 : 0)) * DM;
  for (int base = 0; base < MROWS; base += R * nw) {
    int row[R], vv[R];
    bool act[R];
    float* xr[R];
    f32x4 xv[R][4], fv[R][4];
#pragma unroll
    for (int j = 0; j < R; j++) {
      row[j] = base + j * nw + gw;
      act[j] = row[j] < MROWS;
      int rr = act[j] ? row[j] : 0;
      int b = rr >= NPB ? 1 : 0;
      int n = rr - b * NPB;
      vv[j] = n < 8192 ? b : 2;
      if (mode == 2 && l == 3 && vv[j] == 2) act[j] = false;
      xr[j] = xrow(P, rr);
    }
#pragma unroll
    for (int j = 0; j < R; j++)
      if (act[j]) {
#pragma unroll
        for (int q = 0; q < 4; q++) xv[j][q] = *(const f32x4*)(xr[j] + (q * 64 + lane) * 4);
        if (mode != 0) {
#pragma unroll
          for (int q = 0; q < 4; q++) fv[j][q] = *(const f32x4*)(F + (size_t)row[j] * DM + (q * 64 + lane) * 4);
        }
      }
    if (mode != 0) {
      float rinv[R];
#pragma unroll
      for (int j = 0; j < R; j++) {
        float ss = 0.f;
        if (act[j]) {
#pragma unroll
          for (int q = 0; q < 4; q++) ss += fv[j][q][0] * fv[j][q][0] + fv[j][q][1] * fv[j][q][1] + fv[j][q][2] * fv[j][q][2] + fv[j][q][3] * fv[j][q][3];
        }
        ss = wave_sum(ss);
        rinv[j] = rsqrtf(ss * (1.f / 1024.f) + EPS);
      }
#pragma unroll
      for (int q = 0; q < 4; q++) {
        int c = (q * 64 + lane) * 4;
        f32x4 gn = *(const f32x4*)(gainF + c);
#pragma unroll
        for (int j = 0; j < R; j++)
          if (act[j]) {
            f32x4 gt = *(const f32x4*)(MOD + ((size_t)l * 3 + vv[j]) * 6144 + (mode == 1 ? 2048 : 5120) + c);
            xv[j][q] += gt * fv[j][q] * gn * rinv[j];
            *(f32x4*)(xr[j] + c) = xv[j][q];
          }
      }
    }
    if (doH) {
      float rinv[R];
#pragma unroll
      for (int j = 0; j < R; j++) {
        float ss = 0.f;
        if (act[j]) {
#pragma unroll
          for (int q = 0; q < 4; q++) ss += xv[j][q][0] * xv[j][q][0] + xv[j][q][1] * xv[j][q][1] + xv[j][q][2] * xv[j][q][2] + xv[j][q][3] * xv[j][q][3];
        }
        ss = wave_sum(ss);
        rinv[j] = rsqrtf(ss * (1.f / 1024.f) + EPS);
      }
#pragma unroll
      for (int q = 0; q < 4; q++) {
        int c = (q * 64 + lane) * 4;
        f32x4 gn = *(const f32x4*)(gainH + c);
#pragma unroll
        for (int j = 0; j < R; j++)
          if (act[j]) {
            const float* sh = MOD + ((size_t)lh * 3 + vv[j]) * 6144 + (mode == 1 ? 3072 : 0);
            f32x4 s0 = *(const f32x4*)(sh + c);
            f32x4 s1 = *(const f32x4*)(sh + 1024 + c);
            f32x4 o = xv[j][q] * gn * rinv[j] * (s1 + 1.f) + s0;
            *(uint2*)(H + (size_t)row[j] * DM + c) = pack4(o);
          }
      }
    }
  }
}

template <int NT>
__device__ __forceinline__ void zgemm_tile(char* ws, int m0, int n0, u16* sA, u16* sB, int tq) {
  const u16* A = (const u16*)(ws + O_HBF);
  const u16* Bt = (const u16*)(ws + O_WINA);
  u16* Z = (u16*)(ws + O_Z);
  u16* VtNA = (u16*)(ws + O_VTNA);
  u16* Km = (u16*)(ws + O_KM);
  float* AB = (float*)(ws + O_AB);
  const int quad = (tq & 63) >> 4;
  {
    f32x4 acc[4][NT];
    zero_acc<NT>(acc);
    gemm_main<NT>(A, 1024, Bt, 1024, 1024, m0, n0, acc, sA, sB);
    const bool latent = (m0 % NPB) < 8192;
#pragma unroll
    for (int ni = 0; ni < NT; ni++) {
      int col = GEMM_COL(ni, NT * 32);
      int cb = col & ~15;
#pragma unroll
      for (int mi = 0; mi < 4; mi++) {
        int row = GEMM_ROW(mi);
        int b = row >= NPB ? 1 : 0;
        int n = row - b * NPB;
        f32x4 v = acc[mi][ni];
        if (cb < 2480) *(uint2*)(Z + (size_t)row * ZLD + col) = pack4(v);
        if (cb >= 512 && cb < 768) {
          int h = (col - 512) >> 6, dv = (col - 512) & 63;
#pragma unroll
          for (int r = 0; r < 4; r++) VtNA[((size_t)(b * 4 + h) * 64 + dv + r) * NPB + n] = f2bf(v[r]);
        } else if (cb >= 1152 && cb < 1184) {
          f32x4 o = v;
          if (latent) o = rope4(v, cb == 1152 ? (n >> 6) : (n & 63), quad);
          uint2 pk = pack4(o);
          int rd = col - 1152;
#pragma unroll
          for (int hh = 0; hh < 4; hh++) *(uint2*)(Km + (size_t)row * 384 + hh * 96 + 64 + rd) = pk;
        } else if (cb >= 2208 && cb < 2224) {
          *(float4*)(AB + (size_t)row * 16 + (col - 2208)) = make_float4(v[0], v[1], v[2], v[3]);
        }
      }
    }
  }
}

__device__ __forceinline__ void phase_zgemm(const Params& P, u16* sA, u16* sB) {
  char* ws = opq(P.ws);
  const int tq = TID();
  const int T = 132 * 20, G = gridDim.x;
  const int tail = T % G;
  const bool split = tail > 0 && tail * 4 <= G;
  const int Tfull = split ? T - tail : T;
  for (int t = blockIdx.x; t < Tfull; t += G) zgemm_tile<4>(ws, (t % 132) * 128, (t / 132) * 128, sA, sB, tq);
  if (split && (int)blockIdx.x < tail * 4) {
    const int t = Tfull + (blockIdx.x >> 2), sub = blockIdx.x & 3;
    zgemm_tile<1>(ws, (t % 132) * 128, (t / 132) * 128 + sub * 32, sA, sB, tq);
  }
}

__device__ __forceinline__ void s5_pass1(const Params& P, int l, float* us) {
  const int tid = TID(), lane = tid & 63, w = tid >> 6;
  const u16* Z = (const u16*)(P.ws + O_Z);
  const float* LB = (const float*)(P.ws + O_LB);
  const float* BBR = (const float*)(P.ws + O_BBR);
  const float* BBI = (const float*)(P.ws + O_BBI);
  float* E = (float*)(P.ws + O_S5E);
  for (int it = blockIdx.x; it < 2112; it += gridDim.x) {
    int gq = it & 3, pc = (it >> 2) % NPC, db = (it >> 2) / NPC;
    int dir = db >> 1, b = db & 1;
    __syncthreads();
#pragma unroll
    for (int idx = tid; idx < 4096; idx += 256) {
      int i = idx >> 6, ch = idx & 63;
      int n = tok_n(dir, pc, i);
      us[i * 64 + ch] = bf2f(Z[(size_t)(b * NPB + n) * ZLD + 2224 + gq * 64 + ch]);
    }
    __syncthreads();
    int g = gq * 4 + w;
    size_t sidx = (((size_t)l * 2 + dir) * 16 + g) * 64 + lane;
    float bbr[16], bbi[16];
#pragma unroll
    for (int c = 0; c < 16; c++) {
      bbr[c] = BBR[sidx * 16 + c];
      bbi[c] = BBI[sidx * 16 + c];
    }
    float lr = LB[sidx * 2], li = LB[sidx * 2 + 1];
    float xr = 0.f, xi = 0.f;
    for (int i = 0; i < 64; i++) {
      float br = 0.f, bi = 0.f;
#pragma unroll
      for (int c = 0; c < 16; c++) {
        float u = us[i * 64 + w * 16 + c];
        br += bbr[c] * u;
        bi += bbi[c] * u;
      }
      float nr = lr * xr - li * xi + br;
      float ni = lr * xi + li * xr + bi;
      xr = nr;
      xi = ni;
    }
    size_t o = (((size_t)db * NPC + pc) * 1024 + g * 64 + lane) * 2;
    E[o] = xr;
    E[o + 1] = xi;
  }
}

__device__ __forceinline__ void phase_prep1(const Params& P, int l, float* smf) {
  const int lane = TID() & 63, w = TID() >> 6;
  char* ws = opq(P.ws);
  const u16* Z = (const u16*)(ws + O_Z);
  u16* CQn = (u16*)(ws + O_CQN);
  u16* CKVn = (u16*)(ws + O_CKVN);
  float* GQ = (float*)(ws + O_GQ);
  float* GK = (float*)(ws + O_GK);
  u16* GV = (u16*)(ws + O_GV);
  float* GG = (float*)(ws + O_GG);
  float* GBETA = (float*)(ws + O_GBETA);
  const float* AB = (const float*)(ws + O_AB);
  const float* convw = P.gdn_conv + (size_t)l * 4 * 768;
  for (int row = blockIdx.x * 4 + w; row < MROWS; row += gridDim.x * 4) {
    int b = row >= NPB ? 1 : 0;
    int n = row - b * NPB;
    const u16* zr = Z + (size_t)row * ZLD;
    const int cidx = (lane & 31) * 4;
    const int lo = n < 8192 ? 0 : 8192, hi = n < 8192 ? 8192 : NPB;
    u32x2 raw_cq = *(const u32x2*)(zr + 768 + lane * 4);
    u32x2 raw_kv = *(const u32x2*)(zr + 1024 + cidx);
    u32x2 rawc[4][3];
#pragma unroll
    for (int j = 0; j < 4; j++) {
      int nn = n + j - 2;
      bool ok = nn >= lo && nn < hi;
      const u16* zz = Z + (size_t)(b * NPB + (ok ? nn : n)) * ZLD + 1184 + lane * 4;
#pragma unroll
      for (int part = 0; part < 3; part++) {
        u32x2 t = *(const u32x2*)(zz + part * 256);
        rawc[j][part] = ok ? t : u32x2{0u, 0u};
      }
    }
    float ab_a = 0.f, ab_b = 0.f;
    if (lane < 8) {
      ab_a = AB[(size_t)row * 16 + lane];
      ab_b = AB[(size_t)row * 16 + 8 + lane];
    }
    {
      float v0 = bf2f(raw_cq[0] & 0xffff), v1 = bf2f(raw_cq[0] >> 16), v2 = bf2f(raw_cq[1] & 0xffff), v3 = bf2f(raw_cq[1] >> 16);
      float ss = wave_sum(v0 * v0 + v1 * v1 + v2 * v2 + v3 * v3);
      float rinv = rsqrtf(ss * (1.f / 256.f) + EPS);
      const float* gn = P.mla_q_norm + (size_t)l * 256 + lane * 4;
      f32x4 o = {v0 * rinv * gn[0], v1 * rinv * gn[1], v2 * rinv * gn[2], v3 * rinv * gn[3]};
      *(uint2*)(CQn + (size_t)row * 256 + lane * 4) = pack4(o);
    }
    {
      float v0 = bf2f(raw_kv[0] & 0xffff), v1 = bf2f(raw_kv[0] >> 16), v2 = bf2f(raw_kv[1] & 0xffff), v3 = bf2f(raw_kv[1] >> 16);
      float part = lane < 32 ? (v0 * v0 + v1 * v1 + v2 * v2 + v3 * v3) : 0.f;
      float ss = wave_sum(part);
      float rinv = rsqrtf(ss * (1.f / 128.f) + EPS);
      const float* gn = P.mla_kv_norm + (size_t)l * 128 + cidx;
      f32x4 o = {v0 * rinv * gn[0], v1 * rinv * gn[1], v2 * rinv * gn[2], v3 * rinv * gn[3]};
      if (lane < 32) *(uint2*)(CKVn + (size_t)row * 128 + cidx) = pack4(o);
    }
    {
      f32x4 acc[3];
#pragma unroll
      for (int part = 0; part < 3; part++) acc[part] = f32x4{0.f, 0.f, 0.f, 0.f};
#pragma unroll
      for (int j = 0; j < 4; j++) {
#pragma unroll
        for (int part = 0; part < 3; part++) {
          u32x2 raw = rawc[j][part];
          f32x4 wv = *(const f32x4*)(convw + j * 768 + part * 256 + lane * 4);
          acc[part][0] += wv[0] * bf2f(raw[0] & 0xffff);
          acc[part][1] += wv[1] * bf2f(raw[0] >> 16);
          acc[part][2] += wv[2] * bf2f(raw[1] & 0xffff);
          acc[part][3] += wv[3] * bf2f(raw[1] >> 16);
        }
      }
#pragma unroll
      for (int part = 0; part < 3; part++) {
        f32x4 y;
#pragma unroll
        for (int e = 0; e < 4; e++) y[e] = siluf_(acc[part][e]);
        if (part < 2) {
          float ss = y[0] * y[0] + y[1] * y[1] + y[2] * y[2] + y[3] * y[3];
          ss += __shfl_xor(ss, 1);
          ss += __shfl_xor(ss, 2);
          ss += __shfl_xor(ss, 4);
          ss += __shfl_xor(ss, 8);
          float rinv = rsqrtf(ss + EPS) * (part == 0 ? 0.125f : 1.f);
          *(f32x4*)((part == 0 ? GQ : GK) + (size_t)row * 256 + lane * 4) = y * rinv;
        } else {
          *(uint2*)(GV + (size_t)row * 256 + lane * 4) = pack4(y);
        }
      }
      if (lane < 8) {
        float xx = ab_a + P.gdn_dt_bias[l * 8 + lane];
        float ee = __expf(-fabsf(xx));
        float sp = fmaxf(xx, 0.f) + (ee < 1e-3f ? ee * (1.f - 0.5f * ee) : __logf(1.f + ee));
        GG[(size_t)row * 8 + lane] = -__expf(P.gdn_a_log[l * 8 + lane]) * sp;
        GBETA[(size_t)row * 8 + lane] = 1.f / (1.f + __expf(-ab_b));
      }
    }
  }
  s5_pass1(P, l, smf);
}

__device__ __forceinline__ void gdn_chunk_prep(const Params& P, int it, float* sm) {
  const int tid = TID(), lane = tid & 63, w = tid >> 6;
  const int l15 = lane & 15, kq = lane >> 4;
  char* ws = opq(P.ws);
  const float* GQ = (const float*)(ws + O_GQ);
  const float* GK = (const float*)(ws + O_GK);
  const u16* GV = (const u16*)(ws + O_GV);
  const float* GG = (const float*)(ws + O_GG);
  const float* GBETA = (const float*)(ws + O_GBETA);
  float* GC = (float*)(ws + O_GC);
  float* U = (float*)(ws + O_U) + (size_t)it * 4096;
  float* KC = (float*)(ws + O_KC) + (size_t)it * 4096;
  float* QK = (float*)(ws + O_QK) + (size_t)it * 4096;
  const int pc = it % NPC, dbh = it / NPC;
  const int h = dbh & 3, b = (dbh >> 2) & 1, dir = dbh >> 3;
  float* ks = sm;
  float* qs = sm + 64 * 65;
  float* LmT = sm + 2 * 64 * 65;
  float* gcs = LmT + 64 * 68;
  float* bts = gcs + 64;
  __syncthreads();
#pragma unroll
  for (int idx = tid; idx < 4096; idx += 256) {
    int i = idx >> 6, d = idx & 63;
    size_t row = (size_t)b * NPB + tok_n(dir, pc, i);
    ks[i * 65 + d] = GK[row * 256 + h * 64 + d];
    qs[i * 65 + d] = GQ[row * 256 + h * 64 + d];
  }
  if (w == 0) {
    size_t row = (size_t)b * NPB + tok_n(dir, pc, lane);
    float v = GG[row * 8 + dir * 4 + h];
    bts[lane] = GBETA[row * 8 + dir * 4 + h];
#pragma unroll
    for (int o = 1; o < 64; o <<= 1) {
      float t = __int_as_float(__builtin_amdgcn_ds_bpermute(((lane - o) & 63) << 2, __float_as_int(v)));
      if (lane >= o) v += t;
    }
    gcs[lane] = v;
    GC[(size_t)it * 64 + lane] = v;
  }
  __syncthreads();
  {
    const int rb = w;
    float ka[16], qa[16];
#pragma unroll
    for (int s = 0; s < 16; s++) {
      ka[s] = ks[(rb * 16 + l15) * 65 + 4 * s + kq];
      qa[s] = qs[(rb * 16 + l15) * 65 + 4 * s + kq];
    }
    for (int cb = 0; cb < 4; cb++) {
      f32x4 dkk = {0.f, 0.f, 0.f, 0.f}, dqk = {0.f, 0.f, 0.f, 0.f};
      if (cb <= rb) {
#pragma unroll
        for (int s = 0; s < 16; s++) {
          float bv = ks[(cb * 16 + l15) * 65 + 4 * s + kq];
          dkk = __builtin_amdgcn_mfma_f32_16x16x4f32(ka[s], bv, dkk, 0, 0, 0);
          dqk = __builtin_amdgcn_mfma_f32_16x16x4f32(qa[s], bv, dqk, 0, 0, 0);
        }
      }
      const int j = cb * 16 + l15;
#pragma unroll
      for (int r = 0; r < 4; r++) {
        const int i = rb * 16 + kq * 4 + r;
        float dec = j <= i ? __expf(gcs[i] - gcs[j]) : 0.f;
        LmT[j * 68 + i] = j < i ? bts[i] * dkk[r] * dec : 0.f;
        QK[i * 64 + j] = dqk[r] * dec;
      }
    }
  }
  __syncthreads();
  if (tid < 128) {
    int c = tid;
    float X[64];
    if (c < 64) {
#pragma unroll
      for (int i = 0; i < 64; i++) {
        size_t row = (size_t)b * NPB + tok_n(dir, pc, i);
        X[i] = bf2f(GV[row * 256 + h * 64 + c]) * bts[i];
      }
    } else {
#pragma unroll
      for (int i = 0; i < 64; i++) X[i] = ks[i * 65 + (c - 64)] * bts[i] * __expf(gcs[i]);
    }
#pragma unroll
    for (int j = 0; j < 63; j++) {
      const float xj = X[j];
#pragma unroll
      for (int i4 = (j + 1) / 4; i4 < 16; i4++) {
        f32x4 lv = *(const f32x4*)(LmT + j * 68 + i4 * 4);
#pragma unroll
        for (int e = 0; e < 4; e++)
          if (i4 * 4 + e > j) X[i4 * 4 + e] -= lv[e] * xj;
      }
    }
    float* dst = c < 64 ? U + c : KC + (c - 64);
#pragma unroll
    for (int i = 0; i < 64; i++) dst[i * 64] = X[i];
  }
}

__device__ __forceinline__ void s5_pass2(const Params& P, int l, int idx) {
  const float* LB = (const float*)(P.ws + O_LB);
  const float* E = (const float*)(P.ws + O_S5E);
  float* H = (float*)(P.ws + O_S5H);
  int gp = idx & 1023, db = idx >> 10, dir = db >> 1;
  size_t sidx = ((size_t)l * 2 + dir) * 1024 + gp;
  float lr = LB[sidx * 2], li = LB[sidx * 2 + 1];
#pragma unroll
  for (int s = 0; s < 6; s++) {
    float nr = lr * lr - li * li, ni = 2.f * lr * li;
    lr = nr;
    li = ni;
  }
  float hr = 0.f, hi = 0.f;
#pragma unroll 4
  for (int pc = 0; pc < NPC; pc++) {
    size_t o = (((size_t)db * NPC + pc) * 1024 + gp) * 2;
    float er = E[o], ei = E[o + 1];
    H[o] = hr;
    H[o + 1] = hi;
    float nr = lr * hr - li * hi + er;
    float ni = lr * hi + li * hr + ei;
    hr = nr;
    hi = ni;
  }
}

__device__ __forceinline__ void phase_prep2(const Params& P, int l, u16* sA, u16* sB, float* smf) {
  char* ws = opq(P.ws);
  const int tq = TID();
  const int quad = (tq & 63) >> 4;
  if (blockIdx.x == 0 && tq == 0) *(int*)(ws + O_CNT) = 0;
  if (blockIdx.x < 16) {
    s5_pass2(P, l, blockIdx.x * 256 + tq);
    return;
  }
  const int wid_ = blockIdx.x - 16, nwk_ = gridDim.x - 16;
  for (int c_ = wid_; c_ < 2112; c_ += nwk_) gdn_chunk_prep(P, c_, smf);
  for (int it = wid_; it < 924; it += nwk_) {
    if (it < 396) {
      int m0 = (it % 132) * 128, n0 = (it / 132) * 128;
      f32x4 acc[4][4];
      zero_acc<4>(acc);
      gemm_main<4>((const u16*)(ws + O_CQN), 256, (const u16*)(ws + O_WUQ), 256, 256, m0, n0, acc, sA, sB);
      u16* Qm = (u16*)(ws + O_QM);
      const bool latent = (m0 % NPB) < 8192;
#pragma unroll
      for (int ni = 0; ni < 4; ni++) {
        int col = GEMM_COL(ni, 128);
        int hb = ((col >> 4) % 6);
#pragma unroll
        for (int mi = 0; mi < 4; mi++) {
          int row = GEMM_ROW(mi);
          int n = row % NPB;
          f32x4 v = acc[mi][ni];
          if (hb >= 4 && latent) v = rope4(v, hb == 4 ? (n >> 6) : (n & 63), quad);
          *(uint2*)(Qm + (size_t)row * 384 + col) = pack4(v);
        }
      }
    } else {
      int t = it - 396;
      int m0 = (t % 132) * 128, n0 = (t / 132) * 128;
      f32x4 acc[4][4];
      zero_acc<4>(acc);
      gemm_main<4>((const u16*)(ws + O_CKVN), 128, (const u16*)(ws + O_WUKV), 128, 128, m0, n0, acc, sA, sB);
      u16* Km = (u16*)(ws + O_KM);
      u16* VtM = (u16*)(ws + O_VTM);
#pragma unroll
      for (int ni = 0; ni < 4; ni++) {
        int col = GEMM_COL(ni, 128);
        int h = col >> 7, cc = col & 127;
#pragma unroll
        for (int mi = 0; mi < 4; mi++) {
          int row = GEMM_ROW(mi);
          int b = row >= NPB ? 1 : 0;
          int n = row - b * NPB;
          f32x4 v = acc[mi][ni];
          if (cc < 64) {
            *(uint2*)(Km + (size_t)row * 384 + h * 96 + cc) = pack4(v);
          } else {
#pragma unroll
            for (int r = 0; r < 4; r++) VtM[((size_t)(b * 4 + h) * 64 + (cc - 64) + r) * NPB + n] = f2bf(v[r]);
          }
        }
      }
    }
  }
}

template <int DQK, bool NA>
__device__ __forceinline__ void attn_unit(const u16* __restrict__ Q, int ldq, const u16* __restrict__ Kp, int ldk,
                          const u16* __restrict__ Vt, u16* __restrict__ Yo, int q0, int ta0, int ta1, int tb0, int tb1,
                          float scale, const float* __restrict__ rpb, u16* Ks, u16* Vs) {
  constexpr int KS = DQK / 32;
  constexpr int KLD = DQK + 16;
  constexpr int KCH = DQK / 8;
  constexpr int NKR = (64 * KCH) / 256;
  constexpr int KSTG = 64 * 112, VSTG = 64 * 72;
  const float LOG2E = 1.4426950408889634f;
  const int tid = TID(), lane = tid & 63, w = tid >> 6;
  const int l15 = lane & 15, quad = lane >> 4;
  const float scale2 = scale * LOG2E;
  bf16x8 qf[2][KS];
#pragma unroll
  for (int qb = 0; qb < 2; qb++)
#pragma unroll
    for (int ks = 0; ks < KS; ks++)
      qf[qb][ks] = *(const bf16x8*)(Q + (size_t)(q0 + w * 32 + qb * 16 + l15) * ldq + ks * 32 + quad * 8);
  f32x4 oacc[4][2];
#pragma unroll
  for (int i = 0; i < 4; i++)
#pragma unroll
    for (int j = 0; j < 2; j++) oacc[i][j] = f32x4{0.f, 0.f, 0.f, 0.f};
  float mrun[2] = {-INFINITY, -INFINITY}, lrun[2] = {0.f, 0.f};
  int qr[2], qc[2], rs[2], cs[2];
#pragma unroll
  for (int qb = 0; qb < 2; qb++) {
    int qn = q0 + w * 32 + qb * 16 + l15;
    qr[qb] = qn >> 6;
    qc[qb] = qn & 63;
    rs[qb] = min(max(qr[qb] - 4, 0), 120);
    cs[qb] = min(max(qc[qb] - 8, 0), 48);
  }
  const int na = ta1 - ta0;
  const int ntiles = na + (tb1 - tb0);
  u32x4 rk[NKR], rv[2];
  int kkey[NKR], kch[NKR];
#pragma unroll
  for (int j = 0; j < NKR; j++) {
    int c = tid + 256 * j;
    kkey[j] = c / KCH;
    kch[j] = c % KCH;
  }
#define ATT_GLOAD(ti_)                                                                               \
  {                                                                                                  \
    const int kt_ = (ti_) < na ? ta0 + (ti_) : tb0 + ((ti_) - na);                                   \
    _Pragma("unroll") for (int j = 0; j < NKR; j++)                                                  \
        rk[j] = *(const u32x4*)(Kp + (size_t)(kt_ * 64 + kkey[j]) * ldk + kch[j] * 8);              \
    _Pragma("unroll") for (int j = 0; j < 2; j++) {                                                  \
      int c = tid + 256 * j;                                                                         \
      rv[j] = *(const u32x4*)(Vt + (size_t)(c >> 3) * NPB + kt_ * 64 + (c & 7) * 8);                 \
    }                                                                                                \
  }
  ATT_GLOAD(0);
  __syncthreads();
  for (int ti = 0; ti < ntiles; ti++) {
    const int kt = ti < na ? ta0 + ti : tb0 + (ti - na);
    u16* Kst = Ks + (ti & 1) * KSTG;
    u16* Vst = Vs + (ti & 1) * VSTG;
#pragma unroll
    for (int j = 0; j < NKR; j++) *(u32x4*)(Kst + kkey[j] * KLD + kch[j] * 8) = rk[j];
#pragma unroll
    for (int j = 0; j < 2; j++) {
      int c = tid + 256 * j;
      *(u32x4*)(Vst + (c >> 3) * 72 + (c & 7) * 8) = rv[j];
    }
    __syncthreads();
    ATT_GLOAD(min(ti + 1, ntiles - 1));
    f32x4 sacc[4][2];
#pragma unroll
    for (int kb = 0; kb < 4; kb++) {
      sacc[kb][0] = f32x4{0.f, 0.f, 0.f, 0.f};
      sacc[kb][1] = f32x4{0.f, 0.f, 0.f, 0.f};
#pragma unroll
      for (int ks = 0; ks < KS; ks++) {
        bf16x8 kf = *(const bf16x8*)(Kst + (kb * 16 + l15) * KLD + ks * 32 + quad * 8);
        sacc[kb][0] = __builtin_amdgcn_mfma_f32_16x16x32_bf16(kf, qf[0][ks], sacc[kb][0], 0, 0, 0);
        sacc[kb][1] = __builtin_amdgcn_mfma_f32_16x16x32_bf16(kf, qf[1][ks], sacc[kb][1], 0, 0, 0);
      }
    }
    const bool band = NA && kt < 128;
    bf16x8 pf[2][2];
#pragma unroll
    for (int qb = 0; qb < 2; qb++) {
      float mx = -INFINITY;
      float pv[4][4];
      float ls = 0.f;
      float alpha;
      if (band) {
#pragma unroll
        for (int kb = 0; kb < 4; kb++)
#pragma unroll
          for (int r = 0; r < 4; r++) {
            float s = sacc[kb][qb][r] * scale2;
            int kcol = kb * 16 + quad * 4 + r;
            bool ok = (kt >= rs[qb]) && (kt < rs[qb] + 8) && (kcol >= cs[qb]) && (kcol < cs[qb] + 16);
            if (ok) s += rpb[(kt - qr[qb] + 7) * 31 + (kcol - qc[qb] + 15)] * LOG2E;
            else s = -INFINITY;
            sacc[kb][qb][r] = s;
            mx = fmaxf(mx, s);
          }
        mx = fmaxf(mx, __shfl_xor(mx, 16));
        mx = fmaxf(mx, __shfl_xor(mx, 32));
        float mnew = fmaxf(mrun[qb], mx);
        float msafe = mnew == -INFINITY ? 0.f : mnew;
        alpha = __builtin_amdgcn_exp2f(mrun[qb] - msafe);
        mrun[qb] = mnew;
#pragma unroll
        for (int kb = 0; kb < 4; kb++)
#pragma unroll
          for (int r = 0; r < 4; r++) {
            float p = __builtin_amdgcn_exp2f(sacc[kb][qb][r] - msafe);
            ls += p;
            pv[kb][r] = p;
          }
      } else {
#pragma unroll
        for (int kb = 0; kb < 4; kb++)
#pragma unroll
          for (int r = 0; r < 4; r++) mx = fmaxf(mx, sacc[kb][qb][r]);
        mx = fmaxf(mx, __shfl_xor(mx, 16));
        mx = fmaxf(mx, __shfl_xor(mx, 32));
        float mnew = fmaxf(mrun[qb], mx * scale2);
        alpha = __builtin_amdgcn_exp2f(mrun[qb] - mnew);
        mrun[qb] = mnew;
#pragma unroll
        for (int kb = 0; kb < 4; kb++)
#pragma unroll
          for (int r = 0; r < 4; r++) {
            float p = __builtin_amdgcn_exp2f(__builtin_fmaf(sacc[kb][qb][r], scale2, -mnew));
            ls += p;
            pv[kb][r] = p;
          }
      }
      lrun[qb] = lrun[qb] * alpha + ls;
      if (__builtin_amdgcn_ballot_w64(alpha != 1.f) != 0ull) {
#pragma unroll
        for (int dvb = 0; dvb < 4; dvb++) {
          oacc[dvb][qb][0] *= alpha;
          oacc[dvb][qb][1] *= alpha;
          oacc[dvb][qb][2] *= alpha;
          oacc[dvb][qb][3] *= alpha;
        }
      }
#pragma unroll
      for (int kb2 = 0; kb2 < 2; kb2++) {
        u32x4 t;
        t[0] = pk2bf(pv[2 * kb2][0], pv[2 * kb2][1]);
        t[1] = pk2bf(pv[2 * kb2][2], pv[2 * kb2][3]);
        t[2] = pk2bf(pv[2 * kb2 + 1][0], pv[2 * kb2 + 1][1]);
        t[3] = pk2bf(pv[2 * kb2 + 1][2], pv[2 * kb2 + 1][3]);
        pf[qb][kb2] = *(bf16x8*)&t;
      }
    }
#pragma unroll
    for (int kb2 = 0; kb2 < 2; kb2++)
#pragma unroll
      for (int dvb = 0; dvb < 4; dvb++) {
        u32x2 lo = *(const u32x2*)(Vst + (dvb * 16 + l15) * 72 + kb2 * 32 + quad * 4);
        u32x2 hi = *(const u32x2*)(Vst + (dvb * 16 + l15) * 72 + kb2 * 32 + 16 + quad * 4);
        u32x4 vv = {lo[0], lo[1], hi[0], hi[1]};
        bf16x8 vf = *(bf16x8*)&vv;
        oacc[dvb][0] = __builtin_amdgcn_mfma_f32_16x16x32_bf16(vf, pf[0][kb2], oacc[dvb][0], 0, 0, 0);
        oacc[dvb][1] = __builtin_amdgcn_mfma_f32_16x16x32_bf16(vf, pf[1][kb2], oacc[dvb][1], 0, 0, 0);
      }
  }
#undef ATT_GLOAD
#pragma unroll
  for (int qb = 0; qb < 2; qb++) {
    float lt = lrun[qb];
    lt += __shfl_xor(lt, 16);
    lt += __shfl_xor(lt, 32);
    float inv = 1.f / lt;
    int qn = q0 + w * 32 + qb * 16 + l15;
#pragma unroll
    for (int dvb = 0; dvb < 4; dvb++) {
      f32x4 o = oacc[dvb][qb];
      o[0] *= inv; o[1] *= inv; o[2] *= inv; o[3] *= inv;
      *(uint2*)(Yo + (size_t)qn * 1024 + dvb * 16 + quad * 4) = pack4(o);
    }
  }
}

__device__ __forceinline__ void gdn_scan(const Params& P, int chain, float* sm) {
  const int tid = TID(), lane = tid & 63, w = tid >> 6;
  const int l15 = lane & 15, kq = lane >> 4;
  char* ws = opq(P.ws);
  const int sl = chain & 3, dbh = chain >> 2;
  const int h = dbh & 3, b = (dbh >> 2) & 1, dir = dbh >> 3;
  const float* GQ = (const float*)(ws + O_GQ);
  const float* GK = (const float*)(ws + O_GK);
  const float* GC = (const float*)(ws + O_GC);
  float* GO = (float*)(ws + O_GO) + (size_t)dir * MROWS * 256;
  float* Ss = sm;
  float* Vn = sm + 64 * 17;
  float* gcs = Vn + 64 * 17;
  const int arow = w * 16 + l15;
  f32x4 Sacc = {0.f, 0.f, 0.f, 0.f};
  float kcf[16], qkf[16], qdf[16], ktf[16];
  f32x4 uacc;
#define SCAN_LOAD_A(pc_)                                                                              \
  {                                                                                                   \
    const size_t it_ = (size_t)dbh * NPC + (pc_);                                                     \
    const float* KC_ = (const float*)(ws + O_KC) + it_ * 4096;                                        \
    const float* U_ = (const float*)(ws + O_U) + it_ * 4096;                                          \
    const size_t rowq_ = (size_t)b * NPB + tok_n(dir, (pc_), arow);                                   \
    _Pragma("unroll") for (int j = 0; j < 4; j++) {                                                   \
      f32x4 a_ = *(const f32x4*)(KC_ + arow * 64 + kq * 16 + j * 4);                                  \
      kcf[j * 4] = a_[0]; kcf[j * 4 + 1] = a_[1]; kcf[j * 4 + 2] = a_[2]; kcf[j * 4 + 3] = a_[3];     \
      f32x4 q_ = *(const f32x4*)(GQ + rowq_ * 256 + h * 64 + kq * 16 + j * 4);                        \
      qdf[j * 4] = q_[0]; qdf[j * 4 + 1] = q_[1]; qdf[j * 4 + 2] = q_[2]; qdf[j * 4 + 3] = q_[3];     \
    }                                                                                                 \
    _Pragma("unroll") for (int r = 0; r < 4; r++) uacc[r] = U_[(w * 16 + kq * 4 + r) * 64 + sl * 16 + l15]; \
  }
#define SCAN_LOAD_B(pc_)                                                                              \
  {                                                                                                   \
    const size_t it_ = (size_t)dbh * NPC + (pc_);                                                     \
    const float* QK_ = (const float*)(ws + O_QK) + it_ * 4096;                                        \
    _Pragma("unroll") for (int j = 0; j < 4; j++) {                                                   \
      f32x4 c_ = *(const f32x4*)(QK_ + arow * 64 + kq * 16 + j * 4);                                  \
      qkf[j * 4] = c_[0]; qkf[j * 4 + 1] = c_[1]; qkf[j * 4 + 2] = c_[2]; qkf[j * 4 + 3] = c_[3];     \
    }                                                                                                 \
    _Pragma("unroll") for (int s = 0; s < 16; s++) {                                                  \
      const size_t rowk_ = (size_t)b * NPB + tok_n(dir, (pc_), kq * 16 + s);                          \
      ktf[s] = GK[rowk_ * 256 + h * 64 + arow];                                                       \
    }                                                                                                 \
  }
  SCAN_LOAD_A(0);
  SCAN_LOAD_B(0);
  __syncthreads();
  if (tid < 64) gcs[tid] = GC[(size_t)dbh * NPC * 64 + tid];
  for (int r = 0; r < 4; r++) Ss[(w * 16 + kq * 4 + r) * 17 + l15] = 0.f;
  __syncthreads();
  for (int pc = 0; pc < NPC; pc++) {
    const float* gcur = gcs + (pc & 1) * 64;
    const int pcn = min(pc + 1, NPC - 1);
    const float gcl = gcur[63];
    {
      float eg = __expf(gcur[arow]);
#pragma unroll
      for (int s = 0; s < 16; s++) qdf[s] *= eg;
    }
    float sf[16];
#pragma unroll
    for (int s = 0; s < 16; s++) sf[s] = Ss[(kq * 16 + s) * 17 + l15];
    f32x4 pa = {0.f, 0.f, 0.f, 0.f}, od = {0.f, 0.f, 0.f, 0.f};
#pragma unroll
    for (int bb = 0; bb < 2; bb++) {
      bf16x8 sb_ = pack8(sf + bb * 8);
      pa = __builtin_amdgcn_mfma_f32_16x16x32_bf16(pack8(kcf + bb * 8), sb_, pa, 0, 0, 0);
      od = __builtin_amdgcn_mfma_f32_16x16x32_bf16(pack8(qdf + bb * 8), sb_, od, 0, 0, 0);
    }
    f32x4 vn;
#pragma unroll
    for (int r = 0; r < 4; r++) {
      vn[r] = uacc[r] - pa[r];
      Vn[(w * 16 + kq * 4 + r) * 17 + l15] = vn[r];
    }
    __builtin_amdgcn_sched_barrier(0);
    SCAN_LOAD_A(pcn);
    float gcn = 0.f;
    if (tid < 64) gcn = GC[((size_t)dbh * NPC + pcn) * 64 + tid];
    __builtin_amdgcn_sched_barrier(0);
    __syncthreads();
    float vf[16];
#pragma unroll
    for (int s = 0; s < 16; s++) vf[s] = Vn[(kq * 16 + s) * 17 + l15];
    const float gl = __expf(gcl);
#pragma unroll
    for (int r = 0; r < 4; r++) Sacc[r] *= gl;
#pragma unroll
    for (int s = 0; s < 16; s++) ktf[s] *= __expf(gcl - gcur[kq * 16 + s]);
#pragma unroll
    for (int bb = 0; bb < 2; bb++) {
      bf16x8 vb_ = pack8(vf + bb * 8);
      od = __builtin_amdgcn_mfma_f32_16x16x32_bf16(pack8(qkf + bb * 8), vb_, od, 0, 0, 0);
      Sacc = __builtin_amdgcn_mfma_f32_16x16x32_bf16(pack8(ktf + bb * 8), vb_, Sacc, 0, 0, 0);
    }
    __builtin_amdgcn_sched_barrier(0);
    SCAN_LOAD_B(pcn);
    __builtin_amdgcn_sched_barrier(0);
#pragma unroll
    for (int r = 0; r < 4; r++) {
      int i = w * 16 + kq * 4 + r;
      size_t row = (size_t)b * NPB + tok_n(dir, pc, i);
      GO[row * 256 + h * 64 + sl * 16 + l15] = od[r];
      Ss[i * 17 + l15] = Sacc[r];
    }
    if (tid < 64) gcs[((pc + 1) & 1) * 64 + tid] = gcn;
    __syncthreads();
  }
#undef SCAN_LOAD_A
#undef SCAN_LOAD_B
}

__device__ __forceinline__ void s5_pass3(const Params& P, int l, int it, float* sm) {
  const int tid = TID(), lane = tid & 63, w = tid >> 6;
  const int l15 = lane & 15, kq = lane >> 4;
  char* ws = opq(P.ws);
  const u16* Z = (const u16*)(ws + O_Z);
  const float* LB = (const float*)(ws + O_LB);
  const float* BBR = (const float*)(ws + O_BBR);
  const float* BBI = (const float*)(ws + O_BBI);
  const float* H = (const float*)(ws + O_S5H);
  u16* S5P = (u16*)(ws + O_S5PRE);
  const int gq = it & 3, c = (it >> 2) % NPC, b = (it >> 2) / NPC;
  float* us = sm;
  float* Xs = sm + 4096 + w * 16 * 132;
  __syncthreads();
#pragma unroll
  for (int idx = tid; idx < 4096; idx += 256) {
    int i = idx >> 6, ch = idx & 63;
    us[i * 64 + ch] = bf2f(Z[(size_t)(b * NPB + c * 64 + i) * ZLD + 2224 + gq * 64 + ch]);
  }
  __syncthreads();
  const int g = gq * 4 + w;
  f32x4 yacc[4];
#pragma unroll
  for (int i = 0; i < 4; i++) yacc[i] = f32x4{0.f, 0.f, 0.f, 0.f};
  for (int dir = 0; dir < 2; dir++) {
    const int pc = dir == 0 ? (c < 128 ? c + 4 : c - 128) : 131 - c;
    size_t sidx = (((size_t)l * 2 + dir) * 16 + g) * 64 + lane;
    float bbr[16], bbi[16];
#pragma unroll
    for (int cc = 0; cc < 16; cc++) {
      bbr[cc] = BBR[sidx * 16 + cc];
      bbi[cc] = BBI[sidx * 16 + cc];
    }
    const float lr = LB[sidx * 2], li = LB[sidx * 2 + 1];
    bf16x8 cmb[4];
    {
      const float* cre = P.s5_c_re + ((((size_t)l * 2 + dir) * 16 + g) * 16 + l15) * 64;
      const float* cim = P.s5_c_im + ((((size_t)l * 2 + dir) * 16 + g) * 16 + l15) * 64;
#pragma unroll
      for (int bb = 0; bb < 4; bb++) {
        float t[8];
#pragma unroll
        for (int j = 0; j < 8; j++) {
          int k = 32 * bb + 8 * kq + j;
          t[j] = k < 64 ? cre[k] : -cim[k - 64];
        }
        cmb[bb] = pack8(t);
      }
    }
    size_t ho = ((((size_t)(dir * 2 + b)) * NPC + pc) * 1024 + g * 64 + lane) * 2;
    float xr = H[ho], xi = H[ho + 1];
    for (int sb = 0; sb < 4; sb++) {
      for (int jj = 0; jj < 16; jj++) {
        int j = sb * 16 + jj;
        int i = dir ? 63 - j : j;
        float br = 0.f, bi = 0.f;
#pragma unroll
        for (int cc = 0; cc < 16; cc++) {
          float u = us[i * 64 + w * 16 + cc];
          br += bbr[cc] * u;
          bi += bbi[cc] * u;
        }
        float nr = lr * xr - li * xi + br;
        float ni = lr * xi + li * xr + bi;
        xr = nr;
        xi = ni;
        Xs[(i & 15) * 132 + lane] = xr;
        Xs[(i & 15) * 132 + 64 + lane] = xi;
      }
      __syncthreads();
      const int tg = dir ? 3 - sb : sb;
      f32x4 a = yacc[tg];
#pragma unroll
      for (int bb = 0; bb < 4; bb++) {
        f32x4 x0 = *(const f32x4*)(Xs + l15 * 132 + 32 * bb + 8 * kq);
        f32x4 x1 = *(const f32x4*)(Xs + l15 * 132 + 32 * bb + 8 * kq + 4);
        u32x4 tt = {pk2bf(x0[0], x0[1]), pk2bf(x0[2], x0[3]), pk2bf(x1[0], x1[1]), pk2bf(x1[2], x1[3])};
        a = __builtin_amdgcn_mfma_f32_16x16x32_bf16(*(bf16x8*)&tt, cmb[bb], a, 0, 0, 0);
      }
      yacc[tg] = a;
      __syncthreads();
    }
  }
  const float dsk = P.s5_d[(size_t)l * 256 + g * 16 + l15];
#pragma unroll
  for (int tg = 0; tg < 4; tg++)
#pragma unroll
    for (int r = 0; r < 4; r++) {
      int i = tg * 16 + kq * 4 + r;
      float y = yacc[tg][r] + dsk * us[i * 64 + w * 16 + l15];
      float t = tanhf(0.7978845608028654f * (y + 0.044715f * y * y * y));
      y = 0.5f * y * (1.f + t);
      S5P[(size_t)(b * NPB + c * 64 + i) * 256 + g * 16 + l15] = f2bf(y);
    }
}

__device__ __forceinline__ void phase_main(const Params& P, int l, char* smraw) {
  char* ws = opq(P.ws);
  __shared__ int s_item;
  if (blockIdx.x < 64) {
    __builtin_amdgcn_s_setprio(3);
    gdn_scan(P, blockIdx.x, (float*)smraw);
    __builtin_amdgcn_s_setprio(0);
  }
  int* cnt = (int*)(ws + O_CNT);
  const u16* Z = (const u16*)(ws + O_Z);
  u16* Y = (u16*)(ws + O_Y);
  while (true) {
    __syncthreads();
    if (TID() == 0) s_item = atomicAdd(cnt, 1);
    __syncthreads();
    int it = s_item;
    if (it >= 528 + 528 + 1056) break;
    if (it < 1056) {
      const bool mla = it < 528;
      int u = mla ? it : it - 528;
      int bh = u / 66, qt = u % 66;
      int b = bh >> 2, h = bh & 3;
      int q0 = qt * 128;
      u16* Ks = (u16*)smraw;
      u16* Vs = Ks + 2 * 64 * 112;
      if (mla) {
        int ta0 = qt < 64 ? 0 : 128;
        attn_unit<96, false>((const u16*)(ws + O_QM) + (size_t)b * NPB * 384 + h * 96, 384,
                             (const u16*)(ws + O_KM) + (size_t)b * NPB * 384 + h * 96, 384,
                             (const u16*)(ws + O_VTM) + (size_t)bh * 64 * NPB,
                             Y + (size_t)b * NPB * 1024 + 256 + h * 64, q0, ta0, 132, 0, 0,
                             0.10206207261596577f, nullptr, Ks, Vs);
      } else {
        const float* rpb = P.na_rpb + ((size_t)l * 4 + h) * 15 * 31;
        const u16* Qp = Z + (size_t)b * NPB * ZLD + h * 64;
        const u16* Kp = Z + (size_t)b * NPB * ZLD + 256 + h * 64;
        const u16* Vp = (const u16*)(ws + O_VTNA) + (size_t)bh * 64 * NPB;
        u16* Yo = Y + (size_t)b * NPB * 1024 + h * 64;
        if (qt < 64) {
          int r0 = qt * 2;
          int a0 = min(max(r0 - 4, 0), 120), a1 = min(max(r0 + 1 - 4, 0), 120) + 8;
          attn_unit<64, true>(Qp, ZLD, Kp, ZLD, Vp, Yo, q0, a0, a1, 128, 132, 0.125f, rpb, Ks, Vs);
        } else {
          attn_unit<64, false>(Qp, ZLD, Kp, ZLD, Vp, Yo, q0, 128, 132, 0, 0, 0.125f, nullptr, Ks, Vs);
        }
      }
    } else {
      s5_pass3(P, l, it - 1056, (float*)smraw);
    }
  }
}

__device__ __forceinline__ void phase_post(const Params& P, int l, u16* sA, u16* sB) {
  const int tq = TID();
  const int lane = tq & 63, w = tq >> 6;
  char* ws = opq(P.ws);
  const u16* Z = (const u16*)(ws + O_Z);
  u16* Y = (u16*)(ws + O_Y);
  const float* GO0 = (const float*)(ws + O_GO);
  const float* GO1 = GO0 + (size_t)MROWS * 256;
  const float gn = P.gdn_norm[l * 64 + lane];
  for (int row = blockIdx.x * 4 + w; row < MROWS; row += gridDim.x * 4) {
#pragma unroll
    for (int h = 0; h < 4; h++) {
      float o = GO0[(size_t)row * 256 + h * 64 + lane] + GO1[(size_t)row * 256 + h * 64 + lane];
      float ss = wave_sum(o * o);
      float rinv = rsqrtf(ss * (1.f / 64.f) + EPS);
      float z = bf2f(Z[(size_t)row * ZLD + 1952 + h * 64 + lane]);
      Y[(size_t)row * 1024 + 512 + h * 64 + lane] = f2bf(o * rinv * gn * siluf_(z));
    }
  }
  const u16* S5P = (const u16*)(ws + O_S5PRE);
  const float* glub = P.s5_glu_b + (size_t)l * 256;
  for (int t = blockIdx.x; t < 264; t += gridDim.x) {
    int m0 = (t % 132) * 128, n0 = (t / 132) * 128;
    f32x4 acc[4][4];
    zero_acc<4>(acc);
    gemm_main<4>(S5P, 256, (const u16*)(ws + O_WGLU), 256, 256, m0, n0, acc, sA, sB);
#pragma unroll
    for (int ni = 0; ni < 4; ni++) {
      int col = GEMM_COL(ni, 128);
#pragma unroll
      for (int mi = 0; mi < 4; mi++) {
        int row = GEMM_ROW(mi);
        uint2 raw = *(const uint2*)(S5P + (size_t)row * 256 + col);
        f32x4 v = acc[mi][ni], o;
        o[0] = bf2f(raw.x & 0xffff) * sigmoidf_(v[0] + glub[col]);
        o[1] = bf2f(raw.x >> 16) * sigmoidf_(v[1] + glub[col + 1]);
        o[2] = bf2f(raw.y & 0xffff) * sigmoidf_(v[2] + glub[col + 2]);
        o[3] = bf2f(raw.y >> 16) * sigmoidf_(v[3] + glub[col + 3]);
        *(uint2*)(Y + (size_t)row * 1024 + 768 + col) = pack4(o);
      }
    }
  }
}

__device__ __forceinline__ void phase_merge(const Params& P, u16* sA, u16* sB) {
  char* ws = opq(P.ws);
  const u16* Hb = (const u16*)(ws + O_HBF);
  const u16* Y = (const u16*)(ws + O_Y);
  u16* MM = (u16*)(ws + O_MM);
  const int tq = TID();
  for (int t = blockIdx.x; t < 132 * 32; t += gridDim.x) {
    const int m0 = (t % 132) * 128, n0 = (t / 132) * 32;
    u32x2 gp[4][4];
    {
      f32x4 ag[4][4];
      zero_acc<4>(ag);
      const u16* pa = Hb + (size_t)(m0 + (tq >> 3)) * 1024 + (tq & 7) * 8;
      const u16* pbv[4];
#pragma unroll
      for (int j = 0; j < 4; j++) {
        int ni = (tq >> 7) + 2 * (j & 1);
        int grow = ni * 1024 + n0 + (j >> 1) * 16 + ((tq >> 3) & 15);
        pbv[j] = (const u16*)(ws + O_WG) + (size_t)grow * 1024 + (tq & 7) * 8;
      }
      gemm_core<4>(pa, (size_t)32 * 1024, pbv, 1024, ag, sA, sB, tq);
#pragma unroll
      for (int mi = 0; mi < 4; mi++)
#pragma unroll
        for (int ni = 0; ni < 4; ni++) {
          f32x4 g = ag[mi][ni];
          gp[mi][ni] = u32x2{pk2bf(sigmoidf_(g[0]), sigmoidf_(g[1])), pk2bf(sigmoidf_(g[2]), sigmoidf_(g[3]))};
        }
    }
    f32x4 macc[4];
#pragma unroll
    for (int mi = 0; mi < 4; mi++) macc[mi] = f32x4{0.f, 0.f, 0.f, 0.f};
#pragma unroll
    for (int i = 0; i < 4; i++) {
      f32x4 ap[4][1];
      zero_acc<1>(ap);
      gemm_main<1>(Y + i * 256, 1024, (const u16*)(ws + O_WB) + (size_t)i * 1024 * 256, 256, 256, m0, n0, ap, sA, sB);
#pragma unroll
      for (int mi = 0; mi < 4; mi++) {
        u32x2 q = gp[mi][i];
        macc[mi][0] += bf2f(q[0] & 0xffff) * ap[mi][0][0];
        macc[mi][1] += bf2f(q[0] >> 16) * ap[mi][0][1];
        macc[mi][2] += bf2f(q[1] & 0xffff) * ap[mi][0][2];
        macc[mi][3] += bf2f(q[1] >> 16) * ap[mi][0][3];
      }
    }
    const int col = n0 + ((tq >> 6) & 1) * 16 + ((tq & 63) >> 4) * 4;
#pragma unroll
    for (int mi = 0; mi < 4; mi++) {
      int row = m0 + ((tq >> 6) >> 1) * 64 + mi * 16 + (tq & 15);
      *(uint2*)(MM + (size_t)row * 1024 + col) = pack4(macc[mi]);
    }
  }
}

template <int EPI, int NT>
__device__ __forceinline__ void gemm_tile_plain(char* ws, const u16* A, int lda, const u16* Bt, int K, int m0, int n0,
                                                u16* sA, u16* sB, int tq) {
  f32x4 acc[4][NT];
  zero_acc<NT>(acc);
  gemm_main<NT>(A, lda, Bt, K, K, m0, n0, acc, sA, sB);
#pragma unroll
  for (int ni = 0; ni < NT; ni++) {
    int col = GEMM_COL(ni, NT * 32);
#pragma unroll
    for (int mi = 0; mi < 4; mi++) {
      int row = GEMM_ROW(mi);
      f32x4 v = acc[mi][ni];
      if (EPI == 0) {
        *(float4*)((float*)(ws + O_F32) + (size_t)row * 1024 + col) = make_float4(v[0], v[1], v[2], v[3]);
      } else {
        f32x4 o;
#pragma unroll
        for (int r = 0; r < 4; r++) {
          float x = fmaxf(v[r], 0.f);
          o[r] = x * x;
        }
        *(uint2*)((u16*)(ws + O_HID) + (size_t)row * 4096 + col) = pack4(o);
      }
    }
  }
}
template <int EPI>
__device__ __forceinline__ void phase_gemm(const Params& P, const u16* A, int lda, const u16* Bt, int K, int N, u16* sA, u16* sB) {
  char* ws = opq(P.ws);
  const int ntn = N / 128;
  const int tq = TID();
  const int T = 132 * ntn, G = gridDim.x;
  const int tail = T % G;
  const bool split = tail > 0 && tail * 4 <= G;
  const int Tfull = split ? T - tail : T;
  {
    u32x4 ra0[4], rb0[4], ra1[4], rb1[4];
    const u16* pa;
    const u16* pbv[4];
    int t = blockIdx.x;
#define PG_PTRS(t_)                                                                          \
  {                                                                                          \
    const int m0_ = ((t_) % 132) * 128, n0_ = ((t_) / 132) * 128;                            \
    pa = A + (size_t)(m0_ + (tq >> 3)) * lda + (tq & 7) * 8;                                 \
    _Pragma("unroll") for (int j = 0; j < 4; j++)                                            \
        pbv[j] = Bt + (size_t)(n0_ + (tq >> 3) + 32 * j) * K + (tq & 7) * 8;                 \
  }
    if (t < Tfull) {
      PG_PTRS(t);
      gemm_preload<4>(pa, (size_t)32 * lda, pbv, ra0, rb0, ra1, rb1);
    }
    for (; t < Tfull; t += G) {
      const int m0 = (t % 132) * 128, n0 = (t / 132) * 128;
      f32x4 acc[4][4];
      zero_acc<4>(acc);
      gemm_core_r<4, true>(pa, (size_t)32 * lda, pbv, K, acc, sA, sB, tq, ra0, rb0, ra1, rb1);
      if (t + G < Tfull) {
        PG_PTRS(t + G);
        gemm_preload<4>(pa, (size_t)32 * lda, pbv, ra0, rb0, ra1, rb1);
      }
#pragma unroll
      for (int ni = 0; ni < 4; ni++) {
        int col = GEMM_COL(ni, 128);
#pragma unroll
        for (int mi = 0; mi < 4; mi++) {
          int row = GEMM_ROW(mi);
          f32x4 v = acc[mi][ni];
          if (EPI == 0) {
            *(float4*)((float*)(ws + O_F32) + (size_t)row * 1024 + col) = make_float4(v[0], v[1], v[2], v[3]);
          } else {
            f32x4 o;
#pragma unroll
            for (int r = 0; r < 4; r++) {
              float x = fmaxf(v[r], 0.f);
              o[r] = x * x;
            }
            *(uint2*)((u16*)(ws + O_HID) + (size_t)row * 4096 + col) = pack4(o);
          }
        }
      }
    }
#undef PG_PTRS
  }
  if (split && (int)blockIdx.x < tail * 4) {
    const int t = Tfull + (blockIdx.x >> 2), sub = blockIdx.x & 3;
    gemm_tile_plain<EPI, 1>(ws, A, lda, Bt, K, (t % 132) * 128, (t / 132) * 128 + sub * 32, sA, sB, tq);
  }
}

__global__ void __launch_bounds__(256, 2) fwd_megakernel(Params P) {
  cg::grid_group grid = cg::this_grid();
  __shared__ __attribute__((aligned(16))) char smraw[73728];
  u16* sA = (u16*)smraw;
  u16* sB = sA + 128 * 64;
  float* smf = (float*)smraw;
  char* ws = opq(P.ws);
  __shared__ uint4 xb_words;
  if (threadIdx.x == 0) xb_words = make_uint4(0u, 0u, 0u, 0u);
  __syncthreads();

  phase0(P, smf);
  convert_weights(P, 0, smf);
  grid.sync();
  XcdBarrier xb = xcd_barrier_post((unsigned*)(ws + O_BAR), (volatile LAS unsigned*)&xb_words);
  row_phase(P, 0, 0);
  xcd_barrier(xb, (unsigned*)(opq(P.ws) + O_BAR));
  for (int l = 0; l < 4; l++) {
    phase_zgemm(P, sA, sB);
    xcd_barrier(xb, (unsigned*)(opq(P.ws) + O_BAR));
    phase_prep1(P, l, smf);
    xcd_barrier(xb, (unsigned*)(opq(P.ws) + O_BAR));
    phase_prep2(P, l, sA, sB, smf);
    xcd_barrier(xb, (unsigned*)(opq(P.ws) + O_BAR));
    phase_main(P, l, smraw);
    xcd_barrier(xb, (unsigned*)(opq(P.ws) + O_BAR));
    phase_post(P, l, sA, sB);
    xcd_barrier(xb, (unsigned*)(opq(P.ws) + O_BAR));
    phase_merge(P, sA, sB);
    xcd_barrier(xb, (unsigned*)(opq(P.ws) + O_BAR));
    phase_gemm<0>(P, (const u16*)(ws + O_MM), 1024, (const u16*)(ws + O_WO), 1024, 1024, sA, sB);
    xcd_barrier(xb, (unsigned*)(opq(P.ws) + O_BAR));
    row_phase(P, l, 1);
    xcd_barrier(xb, (unsigned*)(opq(P.ws) + O_BAR));
    phase_gemm<1>(P, (const u16*)(ws + O_HBF), 1024, (const u16*)(ws + O_W1), 1024, 4096, sA, sB);
    xcd_barrier(xb, (unsigned*)(opq(P.ws) + O_BAR));
    phase_gemm<0>(P, (const u16*)(ws + O_HID), 4096, (const u16*)(ws + O_W2), 4096, 1024, sA, sB);
    xcd_barrier(xb, (unsigned*)(opq(P.ws) + O_BAR));
    row_phase(P, l, 2);
    if (l < 3) convert_weights(P, l + 1, smf);
    xcd_barrier(xb, (unsigned*)(opq(P.ws) + O_BAR));
  }
}

extern "C" void kernel_launch(void* const* d_in, const int* in_sizes, int n_in, void* d_out, int out_size, void* d_ws,
                              size_t ws_size, hipStream_t stream) {
  static int grid_blocks = 0;
  if (!grid_blocks) {
    int dev = 0, cus = 0, per_cu = 0;
    hipGetDevice(&dev);
    hipDeviceGetAttribute(&cus, hipDeviceAttributeMultiprocessorCount, dev);
    hipOccupancyMaxActiveBlocksPerMultiprocessor(&per_cu, fwd_megakernel, 256, 0);
    if (per_cu > 2) per_cu = 2;
    if (per_cu < 1) per_cu = 1;
    grid_blocks = cus * per_cu;
  }
  Params p{};
  const float** pp = (const float**)&p;
  for (int i = 0; i < 31; i++) pp[i] = (const float*)d_in[i];
  p.out = (float*)d_out;
  p.ws = (char*)d_ws;
  if (ws_size < WS_NEEDED) fprintf(stderr, "workspace too small: %zu < %zu\n", ws_size, (size_t)WS_NEEDED);
  void* args[] = {&p};
  hipError_t e = hipLaunchCooperativeKernel((void*)fwd_megakernel, dim3(grid_blocks), dim3(256), args, 0, stream);
  if (e != hipSuccess) fprintf(stderr, "cooperative launch failed: %s (grid %d)\n", hipGetErrorString(e), grid_blocks);
}
```

```cpp
#include <hip/hip_runtime.h>
#include <hip/hip_cooperative_groups.h>
#include <cstdio>
namespace cg = cooperative_groups;

typedef unsigned short u16;
using bf16x8 = __attribute__((ext_vector_type(8))) short;
using bf16x4 = __attribute__((ext_vector_type(4))) short;
using f32x4 = __attribute__((ext_vector_type(4))) float;
using u32x4 = __attribute__((ext_vector_type(4))) unsigned;
using u32x2 = __attribute__((ext_vector_type(2))) unsigned;

constexpr int DM = 1024;
constexpr int NPB = 8448;
constexpr int MROWS = 16896;
constexpr int ZLD = 2560;
constexpr int NPC = 132;
constexpr float EPS = 1e-6f;

constexpr size_t al256(size_t x) { return (x + 255) & ~(size_t)255; }
constexpr size_t O_WINA = 0;
constexpr size_t O_WG   = O_WINA + (size_t)2560 * 1024 * 2;
constexpr size_t O_WB   = O_WG + (size_t)4096 * 1024 * 2;
constexpr size_t O_WO   = O_WB + (size_t)4 * 1024 * 256 * 2;
constexpr size_t O_W1   = O_WO + (size_t)1024 * 1024 * 2;
constexpr size_t O_W2   = O_W1 + (size_t)4096 * 1024 * 2;
constexpr size_t O_WUQ  = O_W2 + (size_t)4096 * 1024 * 2;
constexpr size_t O_WUKV = O_WUQ + (size_t)384 * 256 * 2;
constexpr size_t O_WGLU = O_WUKV + (size_t)512 * 128 * 2;
constexpr size_t O_MOD  = O_WGLU + (size_t)256 * 256 * 2;
constexpr size_t O_LB   = O_MOD + (size_t)4 * 3 * 6144 * 4;
constexpr size_t O_BBR  = O_LB + (size_t)4 * 2 * 16 * 64 * 2 * 4;
constexpr size_t O_BBI  = O_BBR + (size_t)4 * 2 * 16 * 64 * 16 * 4;
constexpr size_t O_CNT  = O_BBI + (size_t)4 * 2 * 16 * 64 * 16 * 4;
constexpr size_t O_BAR  = O_CNT + 256;
constexpr size_t O_XC   = O_BAR + (size_t)3456 * 4 + 256;
constexpr size_t O_HBF  = O_XC + (size_t)512 * 1024 * 4;
constexpr size_t O_Z    = O_HBF + (size_t)MROWS * 1024 * 2;
constexpr size_t O_Y    = O_Z + (size_t)MROWS * ZLD * 2;
constexpr size_t O_R2   = O_Y + (size_t)MROWS * 1024 * 2;
constexpr size_t O_HID  = O_Z;
constexpr size_t O_F32  = O_R2 + (size_t)18 * 1024 * 1024;
constexpr size_t O_MM   = O_F32 + (size_t)MROWS * 1024 * 4;
constexpr size_t O_QM   = O_R2;
constexpr size_t O_KM   = O_QM + (size_t)MROWS * 384 * 2;
constexpr size_t O_VTM  = O_KM + (size_t)MROWS * 384 * 2;
constexpr size_t O_VTNA = O_VTM + (size_t)8 * 64 * NPB * 2;
constexpr size_t O_AB   = O_VTNA + (size_t)8 * 64 * NPB * 2;
constexpr size_t O_GQ   = O_AB + (size_t)MROWS * 16 * 4;
constexpr size_t O_GK   = O_GQ + (size_t)MROWS * 256 * 4;
constexpr size_t O_GG   = O_GK + (size_t)MROWS * 256 * 4;
constexpr size_t O_GBETA= O_GG + (size_t)MROWS * 8 * 4;
constexpr size_t O_GC   = O_GBETA + (size_t)MROWS * 8 * 4;
constexpr size_t O_U    = O_GC + (size_t)2112 * 64 * 4;
constexpr size_t O_KC   = O_U + (size_t)2112 * 4096 * 4;
constexpr size_t O_QK   = O_KC + (size_t)2112 * 4096 * 4;
constexpr size_t O_S5H  = O_QK + (size_t)2112 * 4096 * 4;
constexpr size_t O_S5PRE= O_S5H + (size_t)4 * NPC * 1024 * 2 * 4;
constexpr size_t O_GO   = O_S5PRE + (size_t)MROWS * 256 * 2;
constexpr size_t O_CQN  = O_GO;
constexpr size_t O_CKVN = O_CQN + (size_t)MROWS * 256 * 2;
constexpr size_t O_GV   = O_CKVN + (size_t)MROWS * 128 * 2;
constexpr size_t O_S5E  = O_GV + (size_t)MROWS * 256 * 2;
constexpr size_t O_END  = O_GO + (size_t)2 * MROWS * 256 * 4;
constexpr size_t WS_NEEDED = (O_END > O_MM + (size_t)MROWS * 1024 * 2) ? O_END : (O_MM + (size_t)MROWS * 1024 * 2);

struct Params {
  const float *x, *c, *ctx, *c_ctx, *ada_w, *ada_b, *norm_gains, *w_in, *na_rpb, *mla_q_norm, *mla_kv_norm,
      *mla_w_uq, *mla_w_ukv, *gdn_conv, *gdn_a_log, *gdn_dt_bias, *gdn_norm, *s5_a_re, *s5_a_im, *s5_log_dt,
      *s5_b_re, *s5_b_im, *s5_c_re, *s5_c_im, *s5_d, *s5_glu_w, *s5_glu_b, *w_branch, *w_out, *mlp_w1, *mlp_w2;
  float* out;
  char* ws;
};

__device__ __forceinline__ int TID() {
  int t = __builtin_amdgcn_workitem_id_x();
  asm volatile("" : "+v"(t));
  return t;
}
__device__ __forceinline__ char* opq(char* p) {
  size_t z = 0;
  asm volatile("" : "+s"(z));
  return p + z;
}

typedef __bf16 hbf16x2 __attribute__((ext_vector_type(2)));
typedef float hf32x2 __attribute__((ext_vector_type(2)));
__device__ __forceinline__ unsigned pk2bf(float a, float b) {
  hf32x2 v = {a, b};
  hbf16x2 r = __builtin_convertvector(v, hbf16x2);
  return *(unsigned*)&r;
}
__device__ __forceinline__ u16 f2bf(float f) { return (u16)(pk2bf(f, 0.f) & 0xffffu); }
__device__ __forceinline__ float bf2f(u16 h) { return __uint_as_float(((unsigned)h) << 16); }
__device__ __forceinline__ float sigmoidf_(float x) { return 1.f / (1.f + __expf(-x)); }
__device__ __forceinline__ float siluf_(float x) { return x / (1.f + __expf(-x)); }
__device__ __forceinline__ float wave_sum(float v) {
#pragma unroll
  for (int o = 32; o >= 1; o >>= 1) v += __shfl_xor(v, o);
  return v;
}
__device__ __forceinline__ uint2 pack4(f32x4 v) {
  uint2 r;
  r.x = pk2bf(v[0], v[1]);
  r.y = pk2bf(v[2], v[3]);
  return r;
}
__device__ __forceinline__ bf16x8 pack8(const float* v) {
  u32x4 t = {pk2bf(v[0], v[1]), pk2bf(v[2], v[3]), pk2bf(v[4], v[5]), pk2bf(v[6], v[7])};
  return *(bf16x8*)&t;
}
__device__ __forceinline__ float* xrow(const Params& P, int row) {
  int b = row >= NPB ? 1 : 0;
  int n = row - b * NPB;
  return n < 8192 ? P.out + ((size_t)b * 8192 + n) * DM : (float*)(P.ws + O_XC) + ((size_t)b * 256 + (n - 8192)) * DM;
}
__device__ __forceinline__ int tok_n(int dir, int pc, int i) {
  if (dir == 0) return pc < 4 ? 8192 + pc * 64 + i : (pc - 4) * 64 + i;
  return pc < 4 ? 8192 + (3 - pc) * 64 + 63 - i : (131 - pc) * 64 + 63 - i;
}


#define XB_TMO      128
#define XB_XCNT(j)  (256  + 64 * (j))
#define XB_XSUB(j)  (1280 + 64 * (j))
#define XB_XGEN(j)  (2304 + 64 * (j))
#define XB_TOP      3328
#define XB_TOPGEN   3392
#define XCD_BAR_WORDS 3456
#define XB_SPIN_CAP (1u << 22)
#define LAS __attribute__((address_space(3)))
__device__ __forceinline__ unsigned xb_ld(unsigned* p) { return __hip_atomic_load(p, __ATOMIC_RELAXED, __HIP_MEMORY_SCOPE_AGENT); }
__device__ __forceinline__ unsigned xb_add(unsigned* p, unsigned v) { return __hip_atomic_fetch_add(p, v, __ATOMIC_RELAXED, __HIP_MEMORY_SCOPE_AGENT); }
__device__ __forceinline__ unsigned xb_xcc_id() { return (unsigned)__builtin_amdgcn_readfirstlane((int)(__builtin_amdgcn_s_getreg((3 << 11) | 20) & 0xFu)); }
#define XB_SPIN(cond, bar) do { unsigned _sp = 0; while (cond) { __builtin_amdgcn_s_sleep(1); \
    if ((++_sp & 255u) == 0u) { if (xb_ld(&(bar)[XB_TMO])) break; if (_sp > XB_SPIN_CAP) { atomicAdd(&(bar)[XB_TMO], 1u); break; } } } } while (0)
struct XcdBarrier { unsigned* bar; unsigned x; volatile LAS unsigned* st; };
__device__ __forceinline__ XcdBarrier xcd_barrier_post(unsigned* bar, volatile LAS unsigned* st) {
  XcdBarrier b; b.bar = bar; b.x = xb_xcc_id(); b.st = st;
  if (threadIdx.x == 0) (void)xb_add(&bar[XB_XCNT(b.x)], 1u);
  return b;
}
__device__ __forceinline__ void xcd_barrier_complete(unsigned* bar, unsigned x, unsigned& nloc, unsigned& nx) {
  const unsigned G = gridDim.x * gridDim.y * gridDim.z;
  unsigned sum, cnt, mine, sp = 0u;
  for (;;) {
    sum = 0u; cnt = 0u; mine = 0u;
#pragma unroll
    for (unsigned j = 0; j < 16; ++j) { const unsigned c = xb_ld(&bar[XB_XCNT(j)]); sum += c; cnt += (c > 0u) ? 1u : 0u; mine = (j == x) ? c : mine; }
    if (sum == G) break;
    __builtin_amdgcn_s_sleep(1);
    if ((++sp & 255u) == 0u) { if (xb_ld(&bar[XB_TMO])) break; if (sp > XB_SPIN_CAP) { atomicAdd(&bar[XB_TMO], 1u); break; } }
  }
  nloc = mine > 0u ? mine : 1u; nx = cnt > 0u ? cnt : 1u;
}
__device__ __forceinline__ void xcd_barrier(const XcdBarrier& b, unsigned* bar_in) {
  asm volatile("s_waitcnt vmcnt(0)" ::: "memory");
  __syncthreads();
  if (threadIdx.x == 0) {
    unsigned* bar = bar_in;
    __builtin_amdgcn_s_waitcnt(0);
    unsigned nloc = b.st[0], nx = b.st[1];
    if (nloc == 0u) { xcd_barrier_complete(bar, b.x, nloc, nx); b.st[0] = nloc; b.st[1] = nx; }
    const unsigned old = xb_add(&bar[XB_XSUB(b.x)], 1u);
    const unsigned gen = old / nloc;
    if (old + 1u == (gen + 1u) * nloc) {
      __builtin_amdgcn_fence(__ATOMIC_RELEASE, "agent");
      asm volatile("s_waitcnt vmcnt(0)" ::: "memory");
      const unsigned og = xb_add(&bar[XB_TOP], 1u);
      const unsigned tg = og / nx;
      if (og + 1u == (tg + 1u) * nx) xb_add(&bar[XB_TOPGEN], 1u);
      else XB_SPIN(xb_ld(&bar[XB_TOPGEN]) == tg, bar);
      __builtin_amdgcn_fence(__ATOMIC_ACQUIRE, "agent");
      xb_add(&bar[XB_XGEN(b.x)], 1u);
      asm volatile("s_waitcnt vmcnt(0)" ::: "memory");
    } else {
      XB_SPIN(xb_ld(&bar[XB_XGEN(b.x)]) == gen, bar);
      __builtin_amdgcn_fence(__ATOMIC_ACQUIRE, "agent");
      asm volatile("s_waitcnt vmcnt(0)" ::: "memory");
    }
  }
  __syncthreads();
}

template <int NT, bool PRE>
__device__ __forceinline__ void gemm_core_r(const u16* __restrict__ pa, size_t sa32, const u16* const (&pbv)[NT], int K,
                                            f32x4 (&acc)[4][NT], u16* sA, u16* sB, int tid, u32x4 (&ra0)[4],
                                            u32x4 (&rb0)[NT], u32x4 (&ra1)[4], u32x4 (&rb1)[NT]) {
  constexpr int BN = NT * 32;
  constexpr int NB_ = BN / 32;
  constexpr int STG = 256 * 64;
  const int lane = tid & 63, w = tid >> 6;
  const int wm = w >> 1, wn = w & 1;
#define GLOAD(ra, rb, koff)                                                        \
  {                                                                                \
    _Pragma("unroll") for (int j = 0; j < 4; j++) ra[j] = *(const u32x4*)(pa + j * sa32 + (koff));   \
    _Pragma("unroll") for (int j = 0; j < NB_; j++) rb[j] = *(const u32x4*)(pbv[j] + (koff));         \
  }
  const int wsw = ((tid & 7) ^ ((tid >> 4) & 7)) * 8;
  const int rsw = (lane & 15) >> 1;
#define LSTORE(ra, rb, st)                                                                         \
  {                                                                                                \
    _Pragma("unroll") for (int j = 0; j < 4; j++)                                                  \
        *(u32x4*)(sA + (st) * STG + ((tid >> 3) + 32 * j) * 64 + wsw) = ra[j];                     \
    _Pragma("unroll") for (int j = 0; j < NB_; j++)                                                \
        *(u32x4*)(sB + (st) * STG + ((tid >> 3) + 32 * j) * 64 + wsw) = rb[j];                     \
  }
#define COMPUTE(st)                                                                                                  \
  {                                                                                                                  \
    _Pragma("unroll") for (int ks = 0; ks < 2; ks++) {                                                               \
      bf16x8 af[4], bfr[NT];                                                                                         \
      _Pragma("unroll") for (int mi = 0; mi < 4; mi++) af[mi] =                                                      \
          *(const bf16x8*)(sA + (st) * STG + (wm * 64 + mi * 16 + (lane & 15)) * 64 + (((ks * 4 + (lane >> 4)) ^ rsw) * 8)); \
      _Pragma("unroll") for (int ni = 0; ni < NT; ni++) bfr[ni] =                                                    \
          *(const bf16x8*)(sB + (st) * STG + (wn * (BN / 2) + ni * 16 + (lane & 15)) * 64 + (((ks * 4 + (lane >> 4)) ^ rsw) * 8)); \
      _Pragma("unroll") for (int mi = 0; mi < 4; mi++)                                                               \
        _Pragma("unroll") for (int ni = 0; ni < NT; ni++)                                                            \
          acc[mi][ni] = __builtin_amdgcn_mfma_f32_16x16x32_bf16(bfr[ni], af[mi], acc[mi][ni], 0, 0, 0);              \
    }                                                                                                                \
  }
  if (!PRE) {
    GLOAD(ra0, rb0, 0);
    GLOAD(ra1, rb1, 64);
  }
  __syncthreads();
  for (int k0 = 0; k0 < K; k0 += 128) {
    LSTORE(ra0, rb0, 0);
    __syncthreads();
    GLOAD(ra0, rb0, min(k0 + 128, K - 128));
    __builtin_amdgcn_sched_barrier(0);
    COMPUTE(0);
    LSTORE(ra1, rb1, 1);
    __syncthreads();
    GLOAD(ra1, rb1, min(k0 + 192, K - 64));
    __builtin_amdgcn_sched_barrier(0);
    COMPUTE(1);
  }
#undef GLOAD
#undef LSTORE
#undef COMPUTE
}
template <int NT>
__device__ __forceinline__ void gemm_core(const u16* __restrict__ pa, size_t sa32, const u16* const (&pbv)[NT], int K,
                                          f32x4 (&acc)[4][NT], u16* sA, u16* sB, int tid) {
  u32x4 ra0[4], rb0[NT], ra1[4], rb1[NT];
  gemm_core_r<NT, false>(pa, sa32, pbv, K, acc, sA, sB, tid, ra0, rb0, ra1, rb1);
}
template <int NT>
__device__ __forceinline__ void gemm_preload(const u16* __restrict__ pa, size_t sa32, const u16* const (&pbv)[NT],
                                             u32x4 (&ra0)[4], u32x4 (&rb0)[NT], u32x4 (&ra1)[4], u32x4 (&rb1)[NT]) {
#pragma unroll
  for (int j = 0; j < 4; j++) ra0[j] = *(const u32x4*)(pa + j * sa32);
#pragma unroll
  for (int j = 0; j < NT; j++) rb0[j] = *(const u32x4*)(pbv[j]);
#pragma unroll
  for (int j = 0; j < 4; j++) ra1[j] = *(const u32x4*)(pa + j * sa32 + 64);
#pragma unroll
  for (int j = 0; j < NT; j++) rb1[j] = *(const u32x4*)(pbv[j] + 64);
}
template <int NT>
__device__ __forceinline__ void gemm_main(const u16* __restrict__ A, int lda, const u16* __restrict__ Bt, int ldb,
                                          int K, int m0, int n0, f32x4 (&acc)[4][NT], u16* sA, u16* sB) {
  const int tid = TID();
  const u16* pa = A + (size_t)(m0 + (tid >> 3)) * lda + (tid & 7) * 8;
  const u16* pbv[NT];
#pragma unroll
  for (int j = 0; j < NT; j++) pbv[j] = Bt + (size_t)(n0 + (tid >> 3) + 32 * j) * ldb + (tid & 7) * 8;
  gemm_core<NT>(pa, (size_t)32 * lda, pbv, K, acc, sA, sB, tid);
}
#define GEMM_ROW(mi) (m0 + ((tq >> 6) >> 1) * 64 + (mi) * 16 + (tq & 15))
#define GEMM_COL(ni, BN) (n0 + ((tq >> 6) & 1) * ((BN) / 2) + (ni) * 16 + ((tq & 63) >> 4) * 4)

template <int NT>
__device__ __forceinline__ void zero_acc(f32x4 (&acc)[4][NT]) {
#pragma unroll
  for (int i = 0; i < 4; i++)
#pragma unroll
    for (int j = 0; j < NT; j++) acc[i][j] = f32x4{0.f, 0.f, 0.f, 0.f};
}

__device__ __forceinline__ f32x4 rope4(f32x4 v, int pos, int quad) {
  f32x4 o;
#pragma unroll
  for (int r = 0; r < 4; r++) {
    float partner = __shfl_xor(v[r], 32);
    int i = (quad & 1) * 4 + r;
    float freq = exp2f(-(float)i * (13.287712379549449f / 8.0f));
    float ang = (float)pos * freq;
    float cs = cosf(ang), sn = sinf(ang);
    o[r] = quad < 2 ? v[r] * cs - partner * sn : v[r] * cs + partner * sn;
  }
  return o;
}

__device__ __forceinline__ void conv_tile(const float* __restrict__ src, int ld, int col0, int nvalid, int K, u16* __restrict__ dst,
                          int tile, float* T) {
  const int ktiles = K >> 6;
  const int kt = tile % ktiles, nt = tile / ktiles;
  const int k0 = kt * 64, n0 = nt * 64;
  const int tid = TID(), tx = tid & 63, ty = tid >> 6;
  __syncthreads();
  float tv[16];
#pragma unroll
  for (int r = 0; r < 16; r++) {
    tv[r] = 0.f;
    if (n0 + tx < nvalid) tv[r] = src[(size_t)(k0 + ty + 4 * r) * ld + col0 + n0 + tx];
  }
#pragma unroll
  for (int r = 0; r < 16; r++) T[(ty + 4 * r) * 65 + tx] = tv[r];
  __syncthreads();
#pragma unroll
  for (int j = 0; j < 2; j++) {
    int id = tid + 256 * j;
    int nn = id >> 3, kc = id & 7;
    unsigned pk[4];
#pragma unroll
    for (int e = 0; e < 4; e++) {
      float a = T[(kc * 8 + 2 * e) * 65 + nn], b = T[(kc * 8 + 2 * e + 1) * 65 + nn];
      pk[e] = (unsigned)f2bf(a) | ((unsigned)f2bf(b) << 16);
    }
    *(uint4*)(dst + (size_t)(n0 + nn) * K + k0 + kc * 8) = make_uint4(pk[0], pk[1], pk[2], pk[3]);
  }
}

__device__ __forceinline__ void convert_weights(const Params& P, int l, float* T) {
  char* ws = opq(P.ws);
  const int c1 = 640, c2 = c1 + 1024, c3 = c2 + 256, c4 = c3 + 256, c5 = c4 + 1024, c6 = c5 + 1024, c7 = c6 + 24,
            c8 = c7 + 16, c9 = c8 + 16;
  for (int t = blockIdx.x; t < c9; t += gridDim.x) {
    if (t < c1) conv_tile(P.w_in + (size_t)l * 1024 * 6576, 6576, 0, 2480, 1024, (u16*)(ws + O_WINA), t, T);
    else if (t < c2) conv_tile(P.w_in + (size_t)l * 1024 * 6576, 6576, 2480, 4096, 1024, (u16*)(ws + O_WG), t - c1, T);
    else if (t < c3) {
      int tt = t - c2, i = tt >> 6;
      conv_tile(P.w_branch + ((size_t)l * 4 + i) * 256 * 1024, 1024, 0, 1024, 256, (u16*)(ws + O_WB) + (size_t)i * 1024 * 256, tt & 63, T);
    } else if (t < c4) conv_tile(P.w_out + (size_t)l * 1024 * 1024, 1024, 0, 1024, 1024, (u16*)(ws + O_WO), t - c3, T);
    else if (t < c5) conv_tile(P.mlp_w1 + (size_t)l * 1024 * 4096, 4096, 0, 4096, 1024, (u16*)(ws + O_W1), t - c4, T);
    else if (t < c6) conv_tile(P.mlp_w2 + (size_t)l * 4096 * 1024, 1024, 0, 1024, 4096, (u16*)(ws + O_W2), t - c5, T);
    else if (t < c7) conv_tile(P.mla_w_uq + (size_t)l * 256 * 384, 384, 0, 384, 256, (u16*)(ws + O_WUQ), t - c6, T);
    else if (t < c8) conv_tile(P.mla_w_ukv + (size_t)l * 128 * 512, 512, 0, 512, 128, (u16*)(ws + O_WUKV), t - c7, T);
    else conv_tile(P.s5_glu_w + (size_t)l * 256 * 256, 256, 0, 256, 256, (u16*)(ws + O_WGLU), t - c8, T);
  }
}

__device__ __forceinline__ void phase0(const Params& P, float* sm) {
  const int tid = TID();
  const size_t gtid = (size_t)blockIdx.x * 256 + tid, gsz = (size_t)gridDim.x * 256;
  {
    unsigned* bar = (unsigned*)(P.ws + O_BAR);
    for (size_t i = gtid; i < 3456; i += gsz) bar[i] = 0u;
  }
  {
    const float4* s = (const float4*)P.x;
    float4* d = (float4*)P.out;
#pragma unroll 8
    for (size_t i = gtid; i < (size_t)2 * 8192 * 1024 / 4; i += gsz) d[i] = s[i];
    const float4* s2 = (const float4*)P.ctx;
    float4* d2 = (float4*)(P.ws + O_XC);
    for (size_t i = gtid; i < (size_t)512 * 1024 / 4; i += gsz) d2[i] = s2[i];
  }
  float* MOD = (float*)(P.ws + O_MOD);
  for (int it = blockIdx.x; it < 4 * 96; it += gridDim.x) {
    int l = it / 96, j0 = (it % 96) * 64;
    int jj = tid & 63, kq = tid >> 6;
    float a0 = 0.f, a1 = 0.f, a2 = 0.f;
    const float* W = P.ada_w + (size_t)l * 1024 * 6144 + j0 + jj;
    for (int k = kq * 256; k < kq * 256 + 256; k++) {
      float wv = W[(size_t)k * 6144];
      a0 += siluf_(P.c[k]) * wv;
      a1 += siluf_(P.c[1024 + k]) * wv;
      a2 += siluf_(P.c_ctx[k]) * wv;
    }
    __syncthreads();
    sm[(kq * 3 + 0) * 64 + jj] = a0;
    sm[(kq * 3 + 1) * 64 + jj] = a1;
    sm[(kq * 3 + 2) * 64 + jj] = a2;
    __syncthreads();
    if (tid < 192) {
      int v = tid >> 6;
      float s = sm[(0 * 3 + v) * 64 + jj] + sm[(1 * 3 + v) * 64 + jj] + sm[(2 * 3 + v) * 64 + jj] + sm[(3 * 3 + v) * 64 + jj];
      MOD[((size_t)l * 3 + v) * 6144 + j0 + jj] = s + P.ada_b[(size_t)l * 6144 + j0 + jj];
    }
  }
  float* LB = (float*)(P.ws + O_LB);
  float* BBR = (float*)(P.ws + O_BBR);
  float* BBI = (float*)(P.ws + O_BBI);
  for (size_t i = gtid; i < 8192; i += gsz) {
    int p = i & 63, g = (i >> 6) & 15, dir = (i >> 10) & 1, l = (int)(i >> 11);
    float lam_re = fminf(P.s5_a_re[i], -1e-4f);
    float lam_im = P.s5_a_im[i];
    float dt = expf(P.s5_log_dt[(l * 2 + dir) * 16 + g]);
    float mag = expf(lam_re * dt);
    float lbr = mag * cosf(lam_im * dt), lbi = mag * sinf(lam_im * dt);
    float den = lam_re * lam_re + lam_im * lam_im;
    float fr = ((lbr - 1.f) * lam_re + lbi * lam_im) / den;
    float fi = (lbi * lam_re - (lbr - 1.f) * lam_im) / den;
    LB[i * 2] = lbr;
    LB[i * 2 + 1] = lbi;
    const float* br = P.s5_b_re + (((size_t)l * 16 + g) * 64 + p) * 16;
    const float* bi = P.s5_b_im + (((size_t)l * 16 + g) * 64 + p) * 16;
    for (int c = 0; c < 16; c++) {
      BBR[i * 16 + c] = fr * br[c] - fi * bi[c];
      BBI[i * 16 + c] = fr * bi[c] + fi * br[c];
    }
  }
}

__device__ __forceinline__ void row_phase(const Params& P, int l, int mode) {
  constexpr int R = 3;
  const int tq = TID();
  const int lane = tq & 63, w = tq >> 6;
  char* ws = opq(P.ws);
  const float* __restrict__ MOD = (const float*)(ws + O_MOD);
  const float* __restrict__ F = (const float*)(ws + O_F32);
  u16* H = (u16*)(ws + O_HBF);
  const int lh = mode == 2 ? l + 1 : l;
  const bool doH = lh < 4;
  const int gw = blockIdx.x * 4 + w, nw = gridDim.x * 4;
  const float* __restrict__ gainF = P.norm_gains + ((size_t)l * 4 + (mode == 1 ? 1 : 3)) * DM;
  const float* __restrict__ gainH = P.norm_gains + ((size_t)(doH ? lh : 0) * 4 + (mode == 1 ? 2 : 0)) * DM;
  for (int base = 0; base < MROWS; base += R * nw) {
    int row[R], vv[R];
    bool act[R];
    float* xr[R];
    f32x4 xv[R][4], fv[R][4];
#pragma unroll
    for (int j = 0; j < R; j++) {
      row[j] = base + j * nw + gw;
      act[j] = row[j] < MROWS;
      int rr = act[j] ? row[j] : 0;
      int b = rr >= NPB ? 1 : 0;
      int n = rr - b * NPB;
      vv[j] = n < 8192 ? b : 2;
      if (mode == 2 && l == 3 && vv[j] == 2) act[j] = false;
      xr[j] = xrow(P, rr);
    }
#pragma unroll
    for (int j = 0; j < R; j++)
      if (act[j]) {
#pragma unroll
        for (int q = 0; q < 4; q++) xv[j][q] = *(const f32x4*)(xr[j] + (q * 64 + lane) * 4);
        if (mode != 0) {
#pragma unroll
          for (int q = 0; q < 4; q++) fv[j][q] = *(const f32x4*)(F + (size_t)row[j] * DM + (q * 64 + lane) * 4);
        }
      }
    if (mode != 0) {
      float rinv[R];
#pragma unroll
      for (int j = 0; j < R; j++) {
        float ss = 0.f;
        if (act[j]) {
#pragma unroll
          for (int q = 0; q < 4; q++) ss += fv[j][q][0] * fv[j][q][0] + fv[j][q][1] * fv[j][q][1] + fv[j][q][2] * fv[j][q][2] + fv[j][q][3] * fv[j][q][3];
        }
        ss = wave_sum(ss);
        rinv[j] = rsqrtf(ss * (1.f / 1024.f) + EPS);
      }
#pragma unroll
      for (int q = 0; q < 4; q++) {
        int c = (q * 64 + lane) * 4;
        f32x4 gn = *(const f32x4*)(gainF + c);
#pragma unroll
        for (int j = 0; j < R; j++)
          if (act[j]) {
            f32x4 gt = *(const f32x4*)(MOD + ((size_t)l * 3 + vv[j]) * 6144 + (mode == 1 ? 2048 : 5120) + c);
            xv[j][q] += gt * fv[j][q] * gn * rinv[j];
            *(f32x4*)(xr[j] + c) = xv[j][q];
          }
      }
    }
    if (doH) {
      float rinv[R];
#pragma unroll
      for (int j = 0; j < R; j++) {
        float ss = 0.f;
        if (act[j]) {
#pragma unroll
          for (int q = 0; q < 4; q++) ss += xv[j][q][0] * xv[j][q][0] + xv[j][q][1] * xv[j][q][1] + xv[j][q][2] * xv[j][q][2] + xv[j][q][3] * xv[j][q][3];
        }
        ss = wave_sum(ss);
        rinv[j] = rsqrtf(ss * (1.f / 1024.f) + EPS);
      }
#pragma unroll
      for (int q = 0; q < 4; q++) {
        int c = (q * 64 + lane) * 4;
        f32x4 gn = *(const f32x4*)(gainH + c);
#pragma unroll
        for (int j = 0; j < R; j++)
          if (act[j]) {
            const float* sh = MOD + ((size_t)lh * 3 + vv[j]) * 6144 + (mode == 1 ? 3072 : 0);
            f32x4 s0 = *(const f32x4*)(sh + c);
            f32x4 s1 = *(const f32x4*)(sh + 1024 + c);
            f32x4 o = xv[j][q] * gn * rinv[j] * (s1 + 1.f) + s0;
            *(uint2*)(H + (size_t)row[j] * DM + c) = pack4(o);
          }
      }
    }
  }
}

template <int NT>
__device__ __forceinline__ void zgemm_tile(char* ws, int m0, int n0, u16* sA, u16* sB, int tq) {
  const u16* A = (const u16*)(ws + O_HBF);
  const u16* Bt = (const u16*)(ws + O_WINA);
  u16* Z = (u16*)(ws + O_Z);
  u16* VtNA = (u16*)(ws + O_VTNA);
  u16* Km = (u16*)(ws + O_KM);
  float* AB = (float*)(ws + O_AB);
  const int quad = (tq & 63) >> 4;
  {
    f32x4 acc[4][NT];
    zero_acc<NT>(acc);
    gemm_main<NT>(A, 1024, Bt, 1024, 1024, m0, n0, acc, sA, sB);
    const bool latent = (m0 % NPB) < 8192;
#pragma unroll
    for (int ni = 0; ni < NT; ni++) {
      int col = GEMM_COL(ni, NT * 32);
      int cb = col & ~15;
#pragma unroll
      for (int mi = 0; mi < 4; mi++) {
        int row = GEMM_ROW(mi);
        int b = row >= NPB ? 1 : 0;
        int n = row - b * NPB;
        f32x4 v = acc[mi][ni];
        if (cb < 2480) *(uint2*)(Z + (size_t)row * ZLD + col) = pack4(v);
        if (cb >= 512 && cb < 768) {
          int h = (col - 512) >> 6, dv = (col - 512) & 63;
#pragma unroll
          for (int r = 0; r < 4; r++) VtNA[((size_t)(b * 4 + h) * 64 + dv + r) * NPB + n] = f2bf(v[r]);
        } else if (cb >= 1152 && cb < 1184) {
          f32x4 o = v;
          if (latent) o = rope4(v, cb == 1152 ? (n >> 6) : (n & 63), quad);
          uint2 pk = pack4(o);
          int rd = col - 1152;
#pragma unroll
          for (int hh = 0; hh < 4; hh++) *(uint2*)(Km + (size_t)row * 384 + hh * 96 + 64 + rd) = pk;
        } else if (cb >= 2208 && cb < 2224) {
          *(float4*)(AB + (size_t)row * 16 + (col - 2208)) = make_float4(v[0], v[1], v[2], v[3]);
        }
      }
    }
  }
}

__device__ __forceinline__ void phase_zgemm(const Params& P, u16* sA, u16* sB) {
  char* ws = opq(P.ws);
  const int tq = TID();
  const int T = 132 * 20, G = gridDim.x;
  const int tail = T % G;
  const bool split = tail > 0 && tail * 4 <= G;
  const int Tfull = split ? T - tail : T;
  for (int t = blockIdx.x; t < Tfull; t += G) zgemm_tile<4>(ws, (t % 132) * 128, (t / 132) * 128, sA, sB, tq);
  if (split && (int)blockIdx.x < tail * 4) {
    const int t = Tfull + (blockIdx.x >> 2), sub = blockIdx.x & 3;
    zgemm_tile<1>(ws, (t % 132) * 128, (t / 132) * 128 + sub * 32, sA, sB, tq);
  }
}

__device__ __forceinline__ void s5_pass1(const Params& P, int l, float* us) {
  const int tid = TID(), lane = tid & 63, w = tid >> 6;
  const u16* Z = (const u16*)(P.ws + O_Z);
  const float* LB = (const float*)(P.ws + O_LB);
  const float* BBR = (const float*)(P.ws + O_BBR);
  const float* BBI = (const float*)(P.ws + O_BBI);
  float* E = (float*)(P.ws + O_S5E);
  for (int it = blockIdx.x; it < 2112; it += gridDim.x) {
    int gq = it & 3, pc = (it >> 2) % NPC, db = (it >> 2) / NPC;
    int dir = db >> 1, b = db & 1;
    __syncthreads();
#pragma unroll
    for (int idx = tid; idx < 4096; idx += 256) {
      int i = idx >> 6, ch = idx & 63;
      int n = tok_n(dir, pc, i);
      us[i * 64 + ch] = bf2f(Z[(size_t)(b * NPB + n) * ZLD + 2224 + gq * 64 + ch]);
    }
    __syncthreads();
    int g = gq * 4 + w;
    size_t sidx = (((size_t)l * 2 + dir) * 16 + g) * 64 + lane;
    float bbr[16], bbi[16];
#pragma unroll
    for (int c = 0; c < 16; c++) {
      bbr[c] = BBR[sidx * 16 + c];
      bbi[c] = BBI[sidx * 16 + c];
    }
    float lr = LB[sidx * 2], li = LB[sidx * 2 + 1];
    float xr = 0.f, xi = 0.f;
    for (int i = 0; i < 64; i++) {
      float br = 0.f, bi = 0.f;
#pragma unroll
      for (int c = 0; c < 16; c++) {
        float u = us[i * 64 + w * 16 + c];
        br += bbr[c] * u;
        bi += bbi[c] * u;
      }
      float nr = lr * xr - li * xi + br;
      float ni = lr * xi + li * xr + bi;
      xr = nr;
      xi = ni;
    }
    size_t o = (((size_t)db * NPC + pc) * 1024 + g * 64 + lane) * 2;
    E[o] = xr;
    E[o + 1] = xi;
  }
}

__device__ __forceinline__ void phase_prep1(const Params& P, int l, float* smf) {
  const int lane = TID() & 63, w = TID() >> 6;
  char* ws = opq(P.ws);
  const u16* Z = (const u16*)(ws + O_Z);
  u16* CQn = (u16*)(ws + O_CQN);
  u16* CKVn = (u16*)(ws + O_CKVN);
  float* GQ = (float*)(ws + O_GQ);
  float* GK = (float*)(ws + O_GK);
  u16* GV = (u16*)(ws + O_GV);
  float* GG = (float*)(ws + O_GG);
  float* GBETA = (float*)(ws + O_GBETA);
  const float* AB = (const float*)(ws + O_AB);
  const float* convw = P.gdn_conv + (size_t)l * 4 * 768;
  for (int row = blockIdx.x * 4 + w; row < MROWS; row += gridDim.x * 4) {
    int b = row >= NPB ? 1 : 0;
    int n = row - b * NPB;
    const u16* zr = Z + (size_t)row * ZLD;
    const int cidx = (lane & 31) * 4;
    const int lo = n < 8192 ? 0 : 8192, hi = n < 8192 ? 8192 : NPB;
    u32x2 raw_cq = *(const u32x2*)(zr + 768 + lane * 4);
    u32x2 raw_kv = *(const u32x2*)(zr + 1024 + cidx);
    u32x2 rawc[4][3];
#pragma unroll
    for (int j = 0; j < 4; j++) {
      int nn = n + j - 2;
      bool ok = nn >= lo && nn < hi;
      const u16* zz = Z + (size_t)(b * NPB + (ok ? nn : n)) * ZLD + 1184 + lane * 4;
#pragma unroll
      for (int part = 0; part < 3; part++) {
        u32x2 t = *(const u32x2*)(zz + part * 256);
        rawc[j][part] = ok ? t : u32x2{0u, 0u};
      }
    }
    float ab_a = 0.f, ab_b = 0.f;
    if (lane < 8) {
      ab_a = AB[(size_t)row * 16 + lane];
      ab_b = AB[(size_t)row * 16 + 8 + lane];
    }
    {
      float v0 = bf2f(raw_cq[0] & 0xffff), v1 = bf2f(raw_cq[0] >> 16), v2 = bf2f(raw_cq[1] & 0xffff), v3 = bf2f(raw_cq[1] >> 16);
      float ss = wave_sum(v0 * v0 + v1 * v1 + v2 * v2 + v3 * v3);
      float rinv = rsqrtf(ss * (1.f / 256.f) + EPS);
      const float* gn = P.mla_q_norm + (size_t)l * 256 + lane * 4;
      f32x4 o = {v0 * rinv * gn[0], v1 * rinv * gn[1], v2 * rinv * gn[2], v3 * rinv * gn[3]};
      *(uint2*)(CQn + (size_t)row * 256 + lane * 4) = pack4(o);
    }
    {
      float v0 = bf2f(raw_kv[0] & 0xffff), v1 = bf2f(raw_kv[0] >> 16), v2 = bf2f(raw_kv[1] & 0xffff), v3 = bf2f(raw_kv[1] >> 16);
      float part = lane < 32 ? (v0 * v0 + v1 * v1 + v2 * v2 + v3 * v3) : 0.f;
      float ss = wave_sum(part);
      float rinv = rsqrtf(ss * (1.f / 128.f) + EPS);
      const float* gn = P.mla_kv_norm + (size_t)l * 128 + cidx;
      f32x4 o = {v0 * rinv * gn[0], v1 * rinv * gn[1], v2 * rinv * gn[2], v3 * rinv * gn[3]};
      if (lane < 32) *(uint2*)(CKVn + (size_t)row * 128 + cidx) = pack4(o);
    }
    {
      f32x4 acc[3];
#pragma unroll
      for (int part = 0; part < 3; part++) acc[part] = f32x4{0.f, 0.f, 0.f, 0.f};
#pragma unroll
      for (int j = 0; j < 4; j++) {
#pragma unroll
        for (int part = 0; part < 3; part++) {
          u32x2 raw = rawc[j][part];
          f32x4 wv = *(const f32x4*)(convw + j * 768 + part * 256 + lane * 4);
          acc[part][0] += wv[0] * bf2f(raw[0] & 0xffff);
          acc[part][1] += wv[1] * bf2f(raw[0] >> 16);
          acc[part][2] += wv[2] * bf2f(raw[1] & 0xffff);
          acc[part][3] += wv[3] * bf2f(raw[1] >> 16);
        }
      }
#pragma unroll
      for (int part = 0; part < 3; part++) {
        f32x4 y;
#pragma unroll
        for (int e = 0; e < 4; e++) y[e] = siluf_(acc[part][e]);
        if (part < 2) {
          float ss = y[0] * y[0] + y[1] * y[1] + y[2] * y[2] + y[3] * y[3];
          ss += __shfl_xor(ss, 1);
          ss += __shfl_xor(ss, 2);
          ss += __shfl_xor(ss, 4);
          ss += __shfl_xor(ss, 8);
          float rinv = rsqrtf(ss + EPS) * (part == 0 ? 0.125f : 1.f);
          *(f32x4*)((part == 0 ? GQ : GK) + (size_t)row * 256 + lane * 4) = y * rinv;
        } else {
          *(uint2*)(GV + (size_t)row * 256 + lane * 4) = pack4(y);
        }
      }
      if (lane < 8) {
        float xx = ab_a + P.gdn_dt_bias[l * 8 + lane];
        float ee = __expf(-fabsf(xx));
        float sp = fmaxf(xx, 0.f) + (ee < 1e-3f ? ee * (1.f - 0.5f * ee) : __logf(1.f + ee));
        GG[(size_t)row * 8 + lane] = -__expf(P.gdn_a_log[l * 8 + lane]) * sp;
        GBETA[(size_t)row * 8 + lane] = 1.f / (1.f + __expf(-ab_b));
      }
    }
  }
  s5_pass1(P, l, smf);
}

__device__ __forceinline__ void gdn_chunk_prep(const Params& P, int it, float* sm) {
  const int tid = TID(), lane = tid & 63, w = tid >> 6;
  const int l15 = lane & 15, kq = lane >> 4;
  char* ws = opq(P.ws);
  const float* GQ = (const float*)(ws + O_GQ);
  const float* GK = (const float*)(ws + O_GK);
  const u16* GV = (const u16*)(ws + O_GV);
  const float* GG = (const float*)(ws + O_GG);
  const float* GBETA = (const float*)(ws + O_GBETA);
  float* GC = (float*)(ws + O_GC);
  float* U = (float*)(ws + O_U) + (size_t)it * 4096;
  float* KC = (float*)(ws + O_KC) + (size_t)it * 4096;
  float* QK = (float*)(ws + O_QK) + (size_t)it * 4096;
  const int pc = it % NPC, dbh = it / NPC;
  const int h = dbh & 3, b = (dbh >> 2) & 1, dir = dbh >> 3;
  float* ks = sm;
  float* qs = sm + 64 * 65;
  float* LmT = sm + 2 * 64 * 65;
  float* gcs = LmT + 64 * 68;
  float* bts = gcs + 64;
  __syncthreads();
#pragma unroll
  for (int idx = tid; idx < 4096; idx += 256) {
    int i = idx >> 6, d = idx & 63;
    size_t row = (size_t)b * NPB + tok_n(dir, pc, i);
    ks[i * 65 + d] = GK[row * 256 + h * 64 + d];
    qs[i * 65 + d] = GQ[row * 256 + h * 64 + d];
  }
  if (w == 0) {
    size_t row = (size_t)b * NPB + tok_n(dir, pc, lane);
    float v = GG[row * 8 + dir * 4 + h];
    bts[lane] = GBETA[row * 8 + dir * 4 + h];
#pragma unroll
    for (int o = 1; o < 64; o <<= 1) {
      float t = __int_as_float(__builtin_amdgcn_ds_bpermute(((lane - o) & 63) << 2, __float_as_int(v)));
      if (lane >= o) v += t;
    }
    gcs[lane] = v;
    GC[(size_t)it * 64 + lane] = v;
  }
  __syncthreads();
  {
    const int rb = w;
    bf16x8 kaf[2], qaf[2];
#pragma unroll
    for (int bb = 0; bb < 2; bb++) {
      float tk[8], tqv[8];
#pragma unroll
      for (int j = 0; j < 8; j++) {
        tk[j] = ks[(rb * 16 + l15) * 65 + 32 * bb + 8 * kq + j];
        tqv[j] = qs[(rb * 16 + l15) * 65 + 32 * bb + 8 * kq + j];
      }
      kaf[bb] = pack8(tk);
      qaf[bb] = pack8(tqv);
    }
    for (int cb = 0; cb < 4; cb++) {
      f32x4 dkk = {0.f, 0.f, 0.f, 0.f}, dqk = {0.f, 0.f, 0.f, 0.f};
      if (cb <= rb) {
#pragma unroll
        for (int bb = 0; bb < 2; bb++) {
          float tb[8];
#pragma unroll
          for (int j = 0; j < 8; j++) tb[j] = ks[(cb * 16 + l15) * 65 + 32 * bb + 8 * kq + j];
          const bf16x8 bf_ = pack8(tb);
          dkk = __builtin_amdgcn_mfma_f32_16x16x32_bf16(kaf[bb], bf_, dkk, 0, 0, 0);
          dqk = __builtin_amdgcn_mfma_f32_16x16x32_bf16(qaf[bb], bf_, dqk, 0, 0, 0);
        }
      }
      const int j = cb * 16 + l15;
#pragma unroll
      for (int r = 0; r < 4; r++) {
        const int i = rb * 16 + kq * 4 + r;
        float dec = j <= i ? __expf(gcs[i] - gcs[j]) : 0.f;
        LmT[j * 68 + i] = j < i ? bts[i] * dkk[r] * dec : 0.f;
        QK[i * 64 + j] = dqk[r] * dec;
      }
    }
  }
  __syncthreads();
  if (tid < 128) {
    int c = tid;
    float X[64];
    if (c < 64) {
#pragma unroll
      for (int i = 0; i < 64; i++) {
        size_t row = (size_t)b * NPB + tok_n(dir, pc, i);
        X[i] = bf2f(GV[row * 256 + h * 64 + c]) * bts[i];
      }
    } else {
#pragma unroll
      for (int i = 0; i < 64; i++) X[i] = ks[i * 65 + (c - 64)] * bts[i] * __expf(gcs[i]);
    }
#pragma unroll
    for (int j = 0; j < 63; j++) {
      const float xj = X[j];
#pragma unroll
      for (int i4 = (j + 1) / 4; i4 < 16; i4++) {
        f32x4 lv = *(const f32x4*)(LmT + j * 68 + i4 * 4);
#pragma unroll
        for (int e = 0; e < 4; e++)
          if (i4 * 4 + e > j) X[i4 * 4 + e] -= lv[e] * xj;
      }
    }
    float* dst = c < 64 ? U + c : KC + (c - 64);
#pragma unroll
    for (int i = 0; i < 64; i++) dst[i * 64] = X[i];
  }
}

__device__ __forceinline__ void s5_pass2(const Params& P, int l, int idx) {
  const float* LB = (const float*)(P.ws + O_LB);
  const float* E = (const float*)(P.ws + O_S5E);
  float* H = (float*)(P.ws + O_S5H);
  int gp = idx & 1023, db = idx >> 10, dir = db >> 1;
  size_t sidx = ((size_t)l * 2 + dir) * 1024 + gp;
  float lr = LB[sidx * 2], li = LB[sidx * 2 + 1];
#pragma unroll
  for (int s = 0; s < 6; s++) {
    float nr = lr * lr - li * li, ni = 2.f * lr * li;
    lr = nr;
    li = ni;
  }
  float hr = 0.f, hi = 0.f;
#pragma unroll 4
  for (int pc = 0; pc < NPC; pc++) {
    size_t o = (((size_t)db * NPC + pc) * 1024 + gp) * 2;
    float er = E[o], ei = E[o + 1];
    H[o] = hr;
    H[o + 1] = hi;
    float nr = lr * hr - li * hi + er;
    float ni = lr * hi + li * hr + ei;
    hr = nr;
    hi = ni;
  }
}

__device__ __forceinline__ void phase_prep2(const Params& P, int l, u16* sA, u16* sB, float* smf) {
  char* ws = opq(P.ws);
  const int tq = TID();
  const int quad = (tq & 63) >> 4;
  if (blockIdx.x == 0 && tq == 0) *(int*)(ws + O_CNT) = 0;
  if (blockIdx.x < 16) {
    s5_pass2(P, l, blockIdx.x * 256 + tq);
    return;
  }
  const int wid_ = blockIdx.x - 16, nwk_ = gridDim.x - 16;
  for (int c_ = wid_; c_ < 2112; c_ += nwk_) gdn_chunk_prep(P, c_, smf);
  for (int it = wid_; it < 924; it += nwk_) {
    if (it < 396) {
      int m0 = (it % 132) * 128, n0 = (it / 132) * 128;
      f32x4 acc[4][4];
      zero_acc<4>(acc);
      gemm_main<4>((const u16*)(ws + O_CQN), 256, (const u16*)(ws + O_WUQ), 256, 256, m0, n0, acc, sA, sB);
      u16* Qm = (u16*)(ws + O_QM);
      const bool latent = (m0 % NPB) < 8192;
#pragma unroll
      for (int ni = 0; ni < 4; ni++) {
        int col = GEMM_COL(ni, 128);
        int hb = ((col >> 4) % 6);
#pragma unroll
        for (int mi = 0; mi < 4; mi++) {
          int row = GEMM_ROW(mi);
          int n = row % NPB;
          f32x4 v = acc[mi][ni];
          if (hb >= 4 && latent) v = rope4(v, hb == 4 ? (n >> 6) : (n & 63), quad);
          *(uint2*)(Qm + (size_t)row * 384 + col) = pack4(v);
        }
      }
    } else {
      int t = it - 396;
      int m0 = (t % 132) * 128, n0 = (t / 132) * 128;
      f32x4 acc[4][4];
      zero_acc<4>(acc);
      gemm_main<4>((const u16*)(ws + O_CKVN), 128, (const u16*)(ws + O_WUKV), 128, 128, m0, n0, acc, sA, sB);
      u16* Km = (u16*)(ws + O_KM);
      u16* VtM = (u16*)(ws + O_VTM);
#pragma unroll
      for (int ni = 0; ni < 4; ni++) {
        int col = GEMM_COL(ni, 128);
        int h = col >> 7, cc = col & 127;
#pragma unroll
        for (int mi = 0; mi < 4; mi++) {
          int row = GEMM_ROW(mi);
          int b = row >= NPB ? 1 : 0;
          int n = row - b * NPB;
          f32x4 v = acc[mi][ni];
          if (cc < 64) {
            *(uint2*)(Km + (size_t)row * 384 + h * 96 + cc) = pack4(v);
          } else {
#pragma unroll
            for (int r = 0; r < 4; r++) VtM[((size_t)(b * 4 + h) * 64 + (cc - 64) + r) * NPB + n] = f2bf(v[r]);
          }
        }
      }
    }
  }
}

template <int DQK, bool NA>
__device__ __forceinline__ void attn_unit(const u16* __restrict__ Q, int ldq, const u16* __restrict__ Kp, int ldk,
                          const u16* __restrict__ Vt, u16* __restrict__ Yo, int q0, int ta0, int ta1, int tb0, int tb1,
                          float scale, const float* __restrict__ rpb, u16* Ks, u16* Vs) {
  constexpr int KS = DQK / 32;
  constexpr int KLD = DQK + 16;
  constexpr int KCH = DQK / 8;
  constexpr int NKR = (64 * KCH) / 256;
  constexpr int KSTG = 64 * 112, VSTG = 64 * 72;
  const float LOG2E = 1.4426950408889634f;
  const int tid = TID(), lane = tid & 63, w = tid >> 6;
  const int l15 = lane & 15, quad = lane >> 4;
  const float scale2 = scale * LOG2E;
  bf16x8 qf[2][KS];
#pragma unroll
  for (int qb = 0; qb < 2; qb++)
#pragma unroll
    for (int ks = 0; ks < KS; ks++)
      qf[qb][ks] = *(const bf16x8*)(Q + (size_t)(q0 + w * 32 + qb * 16 + l15) * ldq + ks * 32 + quad * 8);
  f32x4 oacc[4][2];
#pragma unroll
  for (int i = 0; i < 4; i++)
#pragma unroll
    for (int j = 0; j < 2; j++) oacc[i][j] = f32x4{0.f, 0.f, 0.f, 0.f};
  float mrun[2] = {-INFINITY, -INFINITY}, lrun[2] = {0.f, 0.f};
  int qr[2], qc[2], rs[2], cs[2];
#pragma unroll
  for (int qb = 0; qb < 2; qb++) {
    int qn = q0 + w * 32 + qb * 16 + l15;
    qr[qb] = qn >> 6;
    qc[qb] = qn & 63;
    rs[qb] = min(max(qr[qb] - 4, 0), 120);
    cs[qb] = min(max(qc[qb] - 8, 0), 48);
  }
  const int na = ta1 - ta0;
  const int ntiles = na + (tb1 - tb0);
  u32x4 rk[NKR], rv[2];
  int kkey[NKR], kch[NKR];
#pragma unroll
  for (int j = 0; j < NKR; j++) {
    int c = tid + 256 * j;
    kkey[j] = c / KCH;
    kch[j] = c % KCH;
  }
#define ATT_GLOAD(ti_)                                                                               \
  {                                                                                                  \
    const int kt_ = (ti_) < na ? ta0 + (ti_) : tb0 + ((ti_) - na);                                   \
    _Pragma("unroll") for (int j = 0; j < NKR; j++)                                                  \
        rk[j] = *(const u32x4*)(Kp + (size_t)(kt_ * 64 + kkey[j]) * ldk + kch[j] * 8);              \
    _Pragma("unroll") for (int j = 0; j < 2; j++) {                                                  \
      int c = tid + 256 * j;                                                                         \
      rv[j] = *(const u32x4*)(Vt + (size_t)(c >> 3) * NPB + kt_ * 64 + (c & 7) * 8);                 \
    }                                                                                                \
  }
  ATT_GLOAD(0);
  __syncthreads();
  for (int ti = 0; ti < ntiles; ti++) {
    const int kt = ti < na ? ta0 + ti : tb0 + (ti - na);
    u16* Kst = Ks + (ti & 1) * KSTG;
    u16* Vst = Vs + (ti & 1) * VSTG;
#pragma unroll
    for (int j = 0; j < NKR; j++) *(u32x4*)(Kst + kkey[j] * KLD + kch[j] * 8) = rk[j];
#pragma unroll
    for (int j = 0; j < 2; j++) {
      int c = tid + 256 * j;
      *(u32x4*)(Vst + (c >> 3) * 72 + (c & 7) * 8) = rv[j];
    }
    __syncthreads();
    ATT_GLOAD(min(ti + 1, ntiles - 1));
    f32x4 sacc[4][2];
#pragma unroll
    for (int kb = 0; kb < 4; kb++) {
      sacc[kb][0] = f32x4{0.f, 0.f, 0.f, 0.f};
      sacc[kb][1] = f32x4{0.f, 0.f, 0.f, 0.f};
#pragma unroll
      for (int ks = 0; ks < KS; ks++) {
        bf16x8 kf = *(const bf16x8*)(Kst + (kb * 16 + l15) * KLD + ks * 32 + quad * 8);
        sacc[kb][0] = __builtin_amdgcn_mfma_f32_16x16x32_bf16(kf, qf[0][ks], sacc[kb][0], 0, 0, 0);
        sacc[kb][1] = __builtin_amdgcn_mfma_f32_16x16x32_bf16(kf, qf[1][ks], sacc[kb][1], 0, 0, 0);
      }
    }
    const bool band = NA && kt < 128;
    bf16x8 pf[2][2];
#pragma unroll
    for (int qb = 0; qb < 2; qb++) {
      float mx = -INFINITY;
      float pv[4][4];
      float ls = 0.f;
      float alpha;
      if (band) {
#pragma unroll
        for (int kb = 0; kb < 4; kb++)
#pragma unroll
          for (int r = 0; r < 4; r++) {
            float s = sacc[kb][qb][r] * scale2;
            int kcol = kb * 16 + quad * 4 + r;
            bool ok = (kt >= rs[qb]) && (kt < rs[qb] + 8) && (kcol >= cs[qb]) && (kcol < cs[qb] + 16);
            if (ok) s += rpb[(kt - qr[qb] + 7) * 31 + (kcol - qc[qb] + 15)] * LOG2E;
            else s = -INFINITY;
            sacc[kb][qb][r] = s;
            mx = fmaxf(mx, s);
          }
        mx = fmaxf(mx, __shfl_xor(mx, 16));
        mx = fmaxf(mx, __shfl_xor(mx, 32));
        float mnew = fmaxf(mrun[qb], mx);
        float msafe = mnew == -INFINITY ? 0.f : mnew;
        alpha = __builtin_amdgcn_exp2f(mrun[qb] - msafe);
        mrun[qb] = mnew;
#pragma unroll
        for (int kb = 0; kb < 4; kb++)
#pragma unroll
          for (int r = 0; r < 4; r++) {
            float p = __builtin_amdgcn_exp2f(sacc[kb][qb][r] - msafe);
            ls += p;
            pv[kb][r] = p;
          }
      } else {
#pragma unroll
        for (int kb = 0; kb < 4; kb++)
#pragma unroll
          for (int r = 0; r < 4; r++) mx = fmaxf(mx, sacc[kb][qb][r]);
        mx = fmaxf(mx, __shfl_xor(mx, 16));
        mx = fmaxf(mx, __shfl_xor(mx, 32));
        float mnew = fmaxf(mrun[qb], mx * scale2);
        alpha = __builtin_amdgcn_exp2f(mrun[qb] - mnew);
        mrun[qb] = mnew;
#pragma unroll
        for (int kb = 0; kb < 4; kb++)
#pragma unroll
          for (int r = 0; r < 4; r++) {
            float p = __builtin_amdgcn_exp2f(__builtin_fmaf(sacc[kb][qb][r], scale2, -mnew));
            ls += p;
            pv[kb][r] = p;
          }
      }
      lrun[qb] = lrun[qb] * alpha + ls;
      if (__builtin_amdgcn_ballot_w64(alpha != 1.f) != 0ull) {
#pragma unroll
        for (int dvb = 0; dvb < 4; dvb++) {
          oacc[dvb][qb][0] *= alpha;
          oacc[dvb][qb][1] *= alpha;
          oacc[dvb][qb][2] *= alpha;
          oacc[dvb][qb][3] *= alpha;
        }
      }
#pragma unroll
      for (int kb2 = 0; kb2 < 2; kb2++) {
        u32x4 t;
        t[0] = pk2bf(pv[2 * kb2][0], pv[2 * kb2][1]);
        t[1] = pk2bf(pv[2 * kb2][2], pv[2 * kb2][3]);
        t[2] = pk2bf(pv[2 * kb2 + 1][0], pv[2 * kb2 + 1][1]);
        t[3] = pk2bf(pv[2 * kb2 + 1][2], pv[2 * kb2 + 1][3]);
        pf[qb][kb2] = *(bf16x8*)&t;
      }
    }
#pragma unroll
    for (int kb2 = 0; kb2 < 2; kb2++)
#pragma unroll
      for (int dvb = 0; dvb < 4; dvb++) {
        u32x2 lo = *(const u32x2*)(Vst + (dvb * 16 + l15) * 72 + kb2 * 32 + quad * 4);
        u32x2 hi = *(const u32x2*)(Vst + (dvb * 16 + l15) * 72 + kb2 * 32 + 16 + quad * 4);
        u32x4 vv = {lo[0], lo[1], hi[0], hi[1]};
        bf16x8 vf = *(bf16x8*)&vv;
        oacc[dvb][0] = __builtin_amdgcn_mfma_f32_16x16x32_bf16(vf, pf[0][kb2], oacc[dvb][0], 0, 0, 0);
        oacc[dvb][1] = __builtin_amdgcn_mfma_f32_16x16x32_bf16(vf, pf[1][kb2], oacc[dvb][1], 0, 0, 0);
      }
  }
#undef ATT_GLOAD
#pragma unroll
  for (int qb = 0; qb < 2; qb++) {
    float lt = lrun[qb];
    lt += __shfl_xor(lt, 16);
    lt += __shfl_xor(lt, 32);
    float inv = 1.f / lt;
    int qn = q0 + w * 32 + qb * 16 + l15;
#pragma unroll
    for (int dvb = 0; dvb < 4; dvb++) {
      f32x4 o = oacc[dvb][qb];
      o[0] *= inv; o[1] *= inv; o[2] *= inv; o[3] *= inv;
      *(uint2*)(Yo + (size_t)qn * 1024 + dvb * 16 + quad * 4) = pack4(o);
    }
  }
}

__device__ __forceinline__ void gdn_scan(const Params& P, int chain, float* sm) {
  const int tid = TID(), lane = tid & 63, w = tid >> 6;
  const int l15 = lane & 15, kq = lane >> 4;
  char* ws = opq(P.ws);
  const int sl = chain & 3, dbh = chain >> 2;
  const int h = dbh & 3, b = (dbh >> 2) & 1, dir = dbh >> 3;
  const float* GQ = (const float*)(ws + O_GQ);
  const float* GK = (const float*)(ws + O_GK);
  const float* GC = (const float*)(ws + O_GC);
  float* GO = (float*)(ws + O_GO) + (size_t)dir * MROWS * 256;
  float* Ss = sm;
  float* Vn = sm + 64 * 17;
  float* gcs = Vn + 64 * 17;
  const int arow = w * 16 + l15;
  f32x4 Sacc = {0.f, 0.f, 0.f, 0.f};
  float kcf[16], qkf[16], qdf[16], ktf[16];
  f32x4 uacc;
#define SCAN_LOAD_A(pc_)                                                                              \
  {                                                                                                   \
    const size_t it_ = (size_t)dbh * NPC + (pc_);                                                     \
    const float* KC_ = (const float*)(ws + O_KC) + it_ * 4096;                                        \
    const float* U_ = (const float*)(ws + O_U) + it_ * 4096;                                          \
    const size_t rowq_ = (size_t)b * NPB + tok_n(dir, (pc_), arow);                                   \
    _Pragma("unroll") for (int j = 0; j < 4; j++) {                                                   \
      f32x4 a_ = *(const f32x4*)(KC_ + arow * 64 + kq * 16 + j * 4);                                  \
      kcf[j * 4] = a_[0]; kcf[j * 4 + 1] = a_[1]; kcf[j * 4 + 2] = a_[2]; kcf[j * 4 + 3] = a_[3];     \
      f32x4 q_ = *(const f32x4*)(GQ + rowq_ * 256 + h * 64 + kq * 16 + j * 4);                        \
      qdf[j * 4] = q_[0]; qdf[j * 4 + 1] = q_[1]; qdf[j * 4 + 2] = q_[2]; qdf[j * 4 + 3] = q_[3];     \
    }                                                                                                 \
    _Pragma("unroll") for (int r = 0; r < 4; r++) uacc[r] = U_[(w * 16 + kq * 4 + r) * 64 + sl * 16 + l15]; \
  }
#define SCAN_LOAD_B(pc_)                                                                              \
  {                                                                                                   \
    const size_t it_ = (size_t)dbh * NPC + (pc_);                                                     \
    const float* QK_ = (const float*)(ws + O_QK) + it_ * 4096;                                        \
    _Pragma("unroll") for (int j = 0; j < 4; j++) {                                                   \
      f32x4 c_ = *(const f32x4*)(QK_ + arow * 64 + kq * 16 + j * 4);                                  \
      qkf[j * 4] = c_[0]; qkf[j * 4 + 1] = c_[1]; qkf[j * 4 + 2] = c_[2]; qkf[j * 4 + 3] = c_[3];     \
    }                                                                                                 \
    _Pragma("unroll") for (int s = 0; s < 16; s++) {                                                  \
      const size_t rowk_ = (size_t)b * NPB + tok_n(dir, (pc_), kq * 16 + s);                          \
      ktf[s] = GK[rowk_ * 256 + h * 64 + arow];                                                       \
    }                                                                                                 \
  }
  SCAN_LOAD_A(0);
  SCAN_LOAD_B(0);
  __syncthreads();
  if (tid < 64) gcs[tid] = GC[(size_t)dbh * NPC * 64 + tid];
  for (int r = 0; r < 4; r++) Ss[(w * 16 + kq * 4 + r) * 17 + l15] = 0.f;
  __syncthreads();
  for (int pc = 0; pc < NPC; pc++) {
    const float* gcur = gcs + (pc & 1) * 64;
    const int pcn = min(pc + 1, NPC - 1);
    const float gcl = gcur[63];
    {
      float eg = __expf(gcur[arow]);
#pragma unroll
      for (int s = 0; s < 16; s++) qdf[s] *= eg;
    }
    float sf[16];
#pragma unroll
    for (int s = 0; s < 16; s++) sf[s] = Ss[(kq * 16 + s) * 17 + l15];
    f32x4 pa = {0.f, 0.f, 0.f, 0.f}, od = {0.f, 0.f, 0.f, 0.f};
#pragma unroll
    for (int bb = 0; bb < 2; bb++) {
      bf16x8 sb_ = pack8(sf + bb * 8);
      pa = __builtin_amdgcn_mfma_f32_16x16x32_bf16(pack8(kcf + bb * 8), sb_, pa, 0, 0, 0);
      od = __builtin_amdgcn_mfma_f32_16x16x32_bf16(pack8(qdf + bb * 8), sb_, od, 0, 0, 0);
    }
    f32x4 vn;
#pragma unroll
    for (int r = 0; r < 4; r++) {
      vn[r] = uacc[r] - pa[r];
      Vn[(w * 16 + kq * 4 + r) * 17 + l15] = vn[r];
    }
    __builtin_amdgcn_sched_barrier(0);
    SCAN_LOAD_A(pcn);
    float gcn = 0.f;
    if (tid < 64) gcn = GC[((size_t)dbh * NPC + pcn) * 64 + tid];
    __builtin_amdgcn_sched_barrier(0);
    __syncthreads();
    float vf[16];
#pragma unroll
    for (int s = 0; s < 16; s++) vf[s] = Vn[(kq * 16 + s) * 17 + l15];
    const float gl = __expf(gcl);
#pragma unroll
    for (int r = 0; r < 4; r++) Sacc[r] *= gl;
#pragma unroll
    for (int s = 0; s < 16; s++) ktf[s] *= __expf(gcl - gcur[kq * 16 + s]);
#pragma unroll
    for (int bb = 0; bb < 2; bb++) {
      bf16x8 vb_ = pack8(vf + bb * 8);
      od = __builtin_amdgcn_mfma_f32_16x16x32_bf16(pack8(qkf + bb * 8), vb_, od, 0, 0, 0);
      Sacc = __builtin_amdgcn_mfma_f32_16x16x32_bf16(pack8(ktf + bb * 8), vb_, Sacc, 0, 0, 0);
    }
    __builtin_amdgcn_sched_barrier(0);
    SCAN_LOAD_B(pcn);
    __builtin_amdgcn_sched_barrier(0);
#pragma unroll
    for (int r = 0; r < 4; r++) {
      int i = w * 16 + kq * 4 + r;
      size_t row = (size_t)b * NPB + tok_n(dir, pc, i);
      GO[row * 256 + h * 64 + sl * 16 + l15] = od[r];
      Ss[i * 17 + l15] = Sacc[r];
    }
    if (tid < 64) gcs[((pc + 1) & 1) * 64 + tid] = gcn;
    __syncthreads();
  }
#undef SCAN_LOAD_A
#undef SCAN_LOAD_B
}

__device__ __forceinline__ void s5_pass3(const Params& P, int l, int it, float* sm) {
  const int tid = TID(), lane = tid & 63, w = tid >> 6;
  const int l15 = lane & 15, kq = lane >> 4;
  char* ws = opq(P.ws);
  const u16* Z = (const u16*)(ws + O_Z);
  const float* LB = (const float*)(ws + O_LB);
  const float* BBR = (const float*)(ws + O_BBR);
  const float* BBI = (const float*)(ws + O_BBI);
  const float* H = (const float*)(ws + O_S5H);
  u16* S5P = (u16*)(ws + O_S5PRE);
  const int gq = it & 3, c = (it >> 2) % NPC, b = (it >> 2) / NPC;
  float* us = sm;
  float* Xs = sm + 4096 + w * 16 * 132;
  __syncthreads();
#pragma unroll
  for (int idx = tid; idx < 4096; idx += 256) {
    int i = idx >> 6, ch = idx & 63;
    us[i * 64 + ch] = bf2f(Z[(size_t)(b * NPB + c * 64 + i) * ZLD + 2224 + gq * 64 + ch]);
  }
  __syncthreads();
  const int g = gq * 4 + w;
  f32x4 yacc[4];
#pragma unroll
  for (int i = 0; i < 4; i++) yacc[i] = f32x4{0.f, 0.f, 0.f, 0.f};
  for (int dir = 0; dir < 2; dir++) {
    const int pc = dir == 0 ? (c < 128 ? c + 4 : c - 128) : 131 - c;
    size_t sidx = (((size_t)l * 2 + dir) * 16 + g) * 64 + lane;
    float bbr[16], bbi[16];
#pragma unroll
    for (int cc = 0; cc < 16; cc++) {
      bbr[cc] = BBR[sidx * 16 + cc];
      bbi[cc] = BBI[sidx * 16 + cc];
    }
    const float lr = LB[sidx * 2], li = LB[sidx * 2 + 1];
    bf16x8 cmb[4];
    {
      const float* cre = P.s5_c_re + ((((size_t)l * 2 + dir) * 16 + g) * 16 + l15) * 64;
      const float* cim = P.s5_c_im + ((((size_t)l * 2 + dir) * 16 + g) * 16 + l15) * 64;
#pragma unroll
      for (int bb = 0; bb < 4; bb++) {
        float t[8];
#pragma unroll
        for (int j = 0; j < 8; j++) {
          int k = 32 * bb + 8 * kq + j;
          t[j] = k < 64 ? cre[k] : -cim[k - 64];
        }
        cmb[bb] = pack8(t);
      }
    }
    size_t ho = ((((size_t)(dir * 2 + b)) * NPC + pc) * 1024 + g * 64 + lane) * 2;
    float xr = H[ho], xi = H[ho + 1];
    for (int sb = 0; sb < 4; sb++) {
      for (int jj = 0; jj < 16; jj++) {
        int j = sb * 16 + jj;
        int i = dir ? 63 - j : j;
        float br = 0.f, bi = 0.f;
#pragma unroll
        for (int cc = 0; cc < 16; cc++) {
          float u = us[i * 64 + w * 16 + cc];
          br += bbr[cc] * u;
          bi += bbi[cc] * u;
        }
        float nr = lr * xr - li * xi + br;
        float ni = lr * xi + li * xr + bi;
        xr = nr;
        xi = ni;
        Xs[(i & 15) * 132 + lane] = xr;
        Xs[(i & 15) * 132 + 64 + lane] = xi;
      }
      __syncthreads();
      const int tg = dir ? 3 - sb : sb;
      f32x4 a = yacc[tg];
#pragma unroll
      for (int bb = 0; bb < 4; bb++) {
        f32x4 x0 = *(const f32x4*)(Xs + l15 * 132 + 32 * bb + 8 * kq);
        f32x4 x1 = *(const f32x4*)(Xs + l15 * 132 + 32 * bb + 8 * kq + 4);
        u32x4 tt = {pk2bf(x0[0], x0[1]), pk2bf(x0[2], x0[3]), pk2bf(x1[0], x1[1]), pk2bf(x1[2], x1[3])};
        a = __builtin_amdgcn_mfma_f32_16x16x32_bf16(*(bf16x8*)&tt, cmb[bb], a, 0, 0, 0);
      }
      yacc[tg] = a;
      __syncthreads();
    }
  }
  const float dsk = P.s5_d[(size_t)l * 256 + g * 16 + l15];
#pragma unroll
  for (int tg = 0; tg < 4; tg++)
#pragma unroll
    for (int r = 0; r < 4; r++) {
      int i = tg * 16 + kq * 4 + r;
      float y = yacc[tg][r] + dsk * us[i * 64 + w * 16 + l15];
      float t = tanhf(0.7978845608028654f * (y + 0.044715f * y * y * y));
      y = 0.5f * y * (1.f + t);
      S5P[(size_t)(b * NPB + c * 64 + i) * 256 + g * 16 + l15] = f2bf(y);
    }
}

__device__ __forceinline__ void phase_main(const Params& P, int l, char* smraw) {
  char* ws = opq(P.ws);
  __shared__ int s_item;
  if (blockIdx.x < 64) {
    __builtin_amdgcn_s_setprio(3);
    gdn_scan(P, blockIdx.x, (float*)smraw);
    __builtin_amdgcn_s_setprio(0);
  }
  int* cnt = (int*)(ws + O_CNT);
  const u16* Z = (const u16*)(ws + O_Z);
  u16* Y = (u16*)(ws + O_Y);
  while (true) {
    __syncthreads();
    if (TID() == 0) s_item = atomicAdd(cnt, 1);
    __syncthreads();
    int it = s_item;
    if (it >= 528 + 528 + 1056) break;
    if (it < 1056) {
      const bool mla = it < 528;
      int u = mla ? it : it - 528;
      int bh = u / 66, qt = u % 66;
      int b = bh >> 2, h = bh & 3;
      int q0 = qt * 128;
      u16* Ks = (u16*)smraw;
      u16* Vs = Ks + 2 * 64 * 112;
      if (mla) {
        int ta0 = qt < 64 ? 0 : 128;
        attn_unit<96, false>((const u16*)(ws + O_QM) + (size_t)b * NPB * 384 + h * 96, 384,
                             (const u16*)(ws + O_KM) + (size_t)b * NPB * 384 + h * 96, 384,
                             (const u16*)(ws + O_VTM) + (size_t)bh * 64 * NPB,
                             Y + (size_t)b * NPB * 1024 + 256 + h * 64, q0, ta0, 132, 0, 0,
                             0.10206207261596577f, nullptr, Ks, Vs);
      } else {
        const float* rpb = P.na_rpb + ((size_t)l * 4 + h) * 15 * 31;
        const u16* Qp = Z + (size_t)b * NPB * ZLD + h * 64;
        const u16* Kp = Z + (size_t)b * NPB * ZLD + 256 + h * 64;
        const u16* Vp = (const u16*)(ws + O_VTNA) + (size_t)bh * 64 * NPB;
        u16* Yo = Y + (size_t)b * NPB * 1024 + h * 64;
        if (qt < 64) {
          int r0 = qt * 2;
          int a0 = min(max(r0 - 4, 0), 120), a1 = min(max(r0 + 1 - 4, 0), 120) + 8;
          attn_unit<64, true>(Qp, ZLD, Kp, ZLD, Vp, Yo, q0, a0, a1, 128, 132, 0.125f, rpb, Ks, Vs);
        } else {
          attn_unit<64, false>(Qp, ZLD, Kp, ZLD, Vp, Yo, q0, 128, 132, 0, 0, 0.125f, nullptr, Ks, Vs);
        }
      }
    } else {
      s5_pass3(P, l, it - 1056, (float*)smraw);
    }
  }
}

__device__ __forceinline__ void phase_post(const Params& P, int l, u16* sA, u16* sB) {
  const int tq = TID();
  const int lane = tq & 63, w = tq >> 6;
  char* ws = opq(P.ws);
  const u16* Z = (const u16*)(ws + O_Z);
  u16* Y = (u16*)(ws + O_Y);
  const float* GO0 = (const float*)(ws + O_GO);
  const float* GO1 = GO0 + (size_t)MROWS * 256;
  const float gn = P.gdn_norm[l * 64 + lane];
  for (int row = blockIdx.x * 4 + w; row < MROWS; row += gridDim.x * 4) {
#pragma unroll
    for (int h = 0; h < 4; h++) {
      float o = GO0[(size_t)row * 256 + h * 64 + lane] + GO1[(size_t)row * 256 + h * 64 + lane];
      float ss = wave_sum(o * o);
      float rinv = rsqrtf(ss * (1.f / 64.f) + EPS);
      float z = bf2f(Z[(size_t)row * ZLD + 1952 + h * 64 + lane]);
      Y[(size_t)row * 1024 + 512 + h * 64 + lane] = f2bf(o * rinv * gn * siluf_(z));
    }
  }
  const u16* S5P = (const u16*)(ws + O_S5PRE);
  const float* glub = P.s5_glu_b + (size_t)l * 256;
  for (int t = blockIdx.x; t < 264; t += gridDim.x) {
    int m0 = (t % 132) * 128, n0 = (t / 132) * 128;
    f32x4 acc[4][4];
    zero_acc<4>(acc);
    gemm_main<4>(S5P, 256, (const u16*)(ws + O_WGLU), 256, 256, m0, n0, acc, sA, sB);
#pragma unroll
    for (int ni = 0; ni < 4; ni++) {
      int col = GEMM_COL(ni, 128);
#pragma unroll
      for (int mi = 0; mi < 4; mi++) {
        int row = GEMM_ROW(mi);
        uint2 raw = *(const uint2*)(S5P + (size_t)row * 256 + col);
        f32x4 v = acc[mi][ni], o;
        o[0] = bf2f(raw.x & 0xffff) * sigmoidf_(v[0] + glub[col]);
        o[1] = bf2f(raw.x >> 16) * sigmoidf_(v[1] + glub[col + 1]);
        o[2] = bf2f(raw.y & 0xffff) * sigmoidf_(v[2] + glub[col + 2]);
        o[3] = bf2f(raw.y >> 16) * sigmoidf_(v[3] + glub[col + 3]);
        *(uint2*)(Y + (size_t)row * 1024 + 768 + col) = pack4(o);
      }
    }
  }
}

__device__ __forceinline__ void phase_merge(const Params& P, u16* sA, u16* sB) {
  char* ws = opq(P.ws);
  const u16* Hb = (const u16*)(ws + O_HBF);
  const u16* Y = (const u16*)(ws + O_Y);
  u16* MM = (u16*)(ws + O_MM);
  const int tq = TID();
  for (int t = blockIdx.x; t < 132 * 32; t += gridDim.x) {
    const int m0 = (t % 132) * 128, n0 = (t / 132) * 32;
    u32x2 gp[4][4];
    {
      f32x4 ag[4][4];
      zero_acc<4>(ag);
      const u16* pa = Hb + (size_t)(m0 + (tq >> 3)) * 1024 + (tq & 7) * 8;
      const u16* pbv[4];
#pragma unroll
      for (int j = 0; j < 4; j++) {
        int ni = (tq >> 7) + 2 * (j & 1);
        int grow = ni * 1024 + n0 + (j >> 1) * 16 + ((tq >> 3) & 15);
        pbv[j] = (const u16*)(ws + O_WG) + (size_t)grow * 1024 + (tq & 7) * 8;
      }
      gemm_core<4>(pa, (size_t)32 * 1024, pbv, 1024, ag, sA, sB, tq);
#pragma unroll
      for (int mi = 0; mi < 4; mi++)
#pragma unroll
        for (int ni = 0; ni < 4; ni++) {
          f32x4 g = ag[mi][ni];
          gp[mi][ni] = u32x2{pk2bf(sigmoidf_(g[0]), sigmoidf_(g[1])), pk2bf(sigmoidf_(g[2]), sigmoidf_(g[3]))};
        }
    }
    f32x4 macc[4];
#pragma unroll
    for (int mi = 0; mi < 4; mi++) macc[mi] = f32x4{0.f, 0.f, 0.f, 0.f};
#pragma unroll
    for (int i = 0; i < 4; i++) {
      f32x4 ap[4][1];
      zero_acc<1>(ap);
      gemm_main<1>(Y + i * 256, 1024, (const u16*)(ws + O_WB) + (size_t)i * 1024 * 256, 256, 256, m0, n0, ap, sA, sB);
#pragma unroll
      for (int mi = 0; mi < 4; mi++) {
        u32x2 q = gp[mi][i];
        macc[mi][0] += bf2f(q[0] & 0xffff) * ap[mi][0][0];
        macc[mi][1] += bf2f(q[0] >> 16) * ap[mi][0][1];
        macc[mi][2] += bf2f(q[1] & 0xffff) * ap[mi][0][2];
        macc[mi][3] += bf2f(q[1] >> 16) * ap[mi][0][3];
      }
    }
    const int col = n0 + ((tq >> 6) & 1) * 16 + ((tq & 63) >> 4) * 4;
#pragma unroll
    for (int mi = 0; mi < 4; mi++) {
      int row = m0 + ((tq >> 6) >> 1) * 64 + mi * 16 + (tq & 15);
      *(uint2*)(MM + (size_t)row * 1024 + col) = pack4(macc[mi]);
    }
  }
}

template <int EPI, int NT>
__device__ __forceinline__ void gemm_tile_plain(char* ws, const u16* A, int lda, const u16* Bt, int K, int m0, int n0,
                                                u16* sA, u16* sB, int tq) {
  f32x4 acc[4][NT];
  zero_acc<NT>(acc);
  gemm_main<NT>(A, lda, Bt, K, K, m0, n0, acc, sA, sB);
#pragma unroll
  for (int ni = 0; ni < NT; ni++) {
    int col = GEMM_COL(ni, NT * 32);
#pragma unroll
    for (int mi = 0; mi < 4; mi++) {
      int row = GEMM_ROW(mi);
      f32x4 v = acc[mi][ni];
      if (EPI == 0) {
        *(float4*)((float*)(ws + O_F32) + (size_t)row * 1024 + col) = make_float4(v[0], v[1], v[2], v[3]);
      } else {
        f32x4 o;
#pragma unroll
        for (int r = 0; r < 4; r++) {
          float x = fmaxf(v[r], 0.f);
          o[r] = x * x;
        }
        *(uint2*)((u16*)(ws + O_HID) + (size_t)row * 4096 + col) = pack4(o);
      }
    }
  }
}
template <int EPI>
__device__ __forceinline__ void phase_gemm(const Params& P, const u16* A, int lda, const u16* Bt, int K, int N, u16* sA, u16* sB) {
  char* ws = opq(P.ws);
  const int ntn = N / 128;
  const int tq = TID();
  const int T = 132 * ntn, G = gridDim.x;
  const int tail = T % G;
  const bool split = tail > 0 && tail * 4 <= G;
  const int Tfull = split ? T - tail : T;
  {
    u32x4 ra0[4], rb0[4], ra1[4], rb1[4];
    const u16* pa;
    const u16* pbv[4];
    int t = blockIdx.x;
#define PG_PTRS(t_)                                                                          \
  {                                                                                          \
    const int m0_ = ((t_) % 132) * 128, n0_ = ((t_) / 132) * 128;                            \
    pa = A + (size_t)(m0_ + (tq >> 3)) * lda + (tq & 7) * 8;                                 \
    _Pragma("unroll") for (int j = 0; j < 4; j++)                                            \
        pbv[j] = Bt + (size_t)(n0_ + (tq >> 3) + 32 * j) * K + (tq & 7) * 8;                 \
  }
    if (t < Tfull) {
      PG_PTRS(t);
      gemm_preload<4>(pa, (size_t)32 * lda, pbv, ra0, rb0, ra1, rb1);
    }
    for (; t < Tfull; t += G) {
      const int m0 = (t % 132) * 128, n0 = (t / 132) * 128;
      f32x4 acc[4][4];
      zero_acc<4>(acc);
      gemm_core_r<4, true>(pa, (size_t)32 * lda, pbv, K, acc, sA, sB, tq, ra0, rb0, ra1, rb1);
      if (t + G < Tfull) {
        PG_PTRS(t + G);
        gemm_preload<4>(pa, (size_t)32 * lda, pbv, ra0, rb0, ra1, rb1);
      }
#pragma unroll
      for (int ni = 0; ni < 4; ni++) {
        int col = GEMM_COL(ni, 128);
#pragma unroll
        for (int mi = 0; mi < 4; mi++) {
          int row = GEMM_ROW(mi);
          f32x4 v = acc[mi][ni];
          if (EPI == 0) {
            *(float4*)((float*)(ws + O_F32) + (size_t)row * 1024 + col) = make_float4(v[0], v[1], v[2], v[3]);
          } else {
            f32x4 o;
#pragma unroll
            for (int r = 0; r < 4; r++) {
              float x = fmaxf(v[r], 0.f);
              o[r] = x * x;
            }
            *(uint2*)((u16*)(ws + O_HID) + (size_t)row * 4096 + col) = pack4(o);
          }
        }
      }
    }
#undef PG_PTRS
  }
  if (split && (int)blockIdx.x < tail * 4) {
    const int t = Tfull + (blockIdx.x >> 2), sub = blockIdx.x & 3;
    gemm_tile_plain<EPI, 1>(ws, A, lda, Bt, K, (t % 132) * 128, (t / 132) * 128 + sub * 32, sA, sB, tq);
  }
}

__global__ void __launch_bounds__(256, 2) fwd_megakernel(Params P) {
  cg::grid_group grid = cg::this_grid();
  __shared__ __attribute__((aligned(16))) char smraw[73728];
  u16* sA = (u16*)smraw;
  u16* sB = sA + 128 * 64;
  float* smf = (float*)smraw;
  char* ws = opq(P.ws);
  __shared__ uint4 xb_words;
  if (threadIdx.x == 0) xb_words = make_uint4(0u, 0u, 0u, 0u);
  __syncthreads();

  phase0(P, smf);
  convert_weights(P, 0, smf);
  grid.sync();
  XcdBarrier xb = xcd_barrier_post((unsigned*)(ws + O_BAR), (volatile LAS unsigned*)&xb_words);
  row_phase(P, 0, 0);
  xcd_barrier(xb, (unsigned*)(opq(P.ws) + O_BAR));
  for (int l = 0; l < 4; l++) {
    phase_zgemm(P, sA, sB);
    xcd_barrier(xb, (unsigned*)(opq(P.ws) + O_BAR));
    phase_prep1(P, l, smf);
    xcd_barrier(xb, (unsigned*)(opq(P.ws) + O_BAR));
    phase_prep2(P, l, sA, sB, smf);
    xcd_barrier(xb, (unsigned*)(opq(P.ws) + O_BAR));
    phase_main(P, l, smraw);
    xcd_barrier(xb, (unsigned*)(opq(P.ws) + O_BAR));
    phase_post(P, l, sA, sB);
    xcd_barrier(xb, (unsigned*)(opq(P.ws) + O_BAR));
    phase_merge(P, sA, sB);
    xcd_barrier(xb, (unsigned*)(opq(P.ws) + O_BAR));
    phase_gemm<0>(P, (const u16*)(ws + O_MM), 1024, (const u16*)(ws + O_WO), 1024, 1024, sA, sB);
    xcd_barrier(xb, (unsigned*)(opq(P.ws) + O_BAR));
    row_phase(P, l, 1);
    xcd_barrier(xb, (unsigned*)(opq(P.ws) + O_BAR));
    phase_gemm<1>(P, (const u16*)(ws + O_HBF), 1024, (const u16*)(ws + O_W1), 1024, 4096, sA, sB);
    xcd_barrier(xb, (unsigned*)(opq(P.ws) + O_BAR));
    phase_gemm<0>(P, (const u16*)(ws + O_HID), 4096, (const u16*)(ws + O_W2), 4096, 1024, sA, sB);
    xcd_barrier(xb, (unsigned*)(opq(P.ws) + O_BAR));
    row_phase(P, l, 2);
    if (l < 3) convert_weights(P, l + 1, smf);
    xcd_barrier(xb, (unsigned*)(opq(P.ws) + O_BAR));
  }
}

extern "C" void kernel_launch(void* const* d_in, const int* in_sizes, int n_in, void* d_out, int out_size, void* d_ws,
                              size_t ws_size, hipStream_t stream) {
  static int grid_blocks = 0;
  if (!grid_blocks) {
    int dev = 0, cus = 0, per_cu = 0;
    hipGetDevice(&dev);
    hipDeviceGetAttribute(&cus, hipDeviceAttributeMultiprocessorCount, dev);
    hipOccupancyMaxActiveBlocksPerMultiprocessor(&per_cu, fwd_megakernel, 256, 0);
    if (per_cu > 2) per_cu = 2;
    if (per_cu < 1) per_cu = 1;
    grid_blocks = cus * per_cu;
  }
  Params p{};
  const float** pp = (const float**)&p;
  for (int i = 0; i < 31; i++) pp[i] = (const float*)d_in[i];
  p.out = (float*)d_out;
  p.ws = (char*)d_ws;
  if (ws_size < WS_NEEDED) fprintf(stderr, "workspace too small: %zu < %zu\n", ws_size, (size_t)WS_NEEDED);
  void* args[] = {&p};
  hipError_t e = hipLaunchCooperativeKernel((void*)fwd_megakernel, dim3(grid_blocks), dim3(256), args, 0, stream);
  if (e != hipSuccess) fprintf(stderr, "cooperative launch failed: %s (grid %d)\n", hipGetErrorString(e), grid_blocks);
}
```
